# Optimizing an MI355X kernel written in HIP

```python
import math
import jax, jax.numpy as jnp
from jax import lax
import numpy as np

D_MODEL = 1024
BATCH = 16
SEQ = 4096
DEPTH = 1

CHUNK = 64
Q_BLOCK = 128
HEAD_DIM = 64
SB_HEADS = 8
SB_WIDTH = SB_HEADS * HEAD_DIM
DA_HEADS = 4
DA_V_DIM = 2 * HEAD_DIM
DA_QK_WIDTH = DA_HEADS * 2 * HEAD_DIM
DA_V_WIDTH = DA_HEADS * DA_V_DIM
N_BRANCH = 2
IN_SPLITS = (SB_WIDTH, SB_WIDTH, SB_WIDTH, DA_QK_WIDTH, DA_QK_WIDTH, DA_V_WIDTH, N_BRANCH * D_MODEL)
IN_WIDTH = sum(IN_SPLITS)
D_FF = -(-8 * D_MODEL // (3 * 256)) * 256
ROPE_THETA = 10000.0
NORM_EPS = 1e-6
SUBLN_EPS = 1e-5

kernel_name = "hybrid_stickbreak_diffattn_gated_block"


def rms_norm(x, g, eps=NORM_EPS):
    xf = x.astype(jnp.float32)
    y = xf * lax.rsqrt(jnp.mean(xf * xf, axis=-1, keepdims=True) + eps)
    return (y * g.astype(jnp.float32)).astype(x.dtype)


def rope_tables(seq_len):
    inv_freq = 1.0 / (ROPE_THETA ** (jnp.arange(0, HEAD_DIM, 2, dtype=jnp.float32) / HEAD_DIM))
    ang = jnp.arange(seq_len, dtype=jnp.float32)[:, None] * inv_freq[None, :]
    ang = jnp.concatenate([ang, ang], axis=-1)
    return jnp.cos(ang), jnp.sin(ang)


def apply_rope(x, cos, sin):
    half = HEAD_DIM // 2
    rot = jnp.concatenate([-x[..., half:], x[..., :half]], axis=-1)
    c = cos[None, :, None, :].astype(x.dtype)
    s = sin[None, :, None, :].astype(x.dtype)
    return x * c + rot * s


def stick_breaking_attention(q, k, v):
    seq_len = q.shape[2]
    scale = HEAD_DIM ** -0.5
    outs = []
    for i in range(seq_len // Q_BLOCK):
        start, end = i * Q_BLOCK, (i + 1) * Q_BLOCK
        z = jnp.einsum('bhqd,bhkd->bhqk', q[:, :, start:end], k[:, :, :end]).astype(jnp.float32) * scale
        qpos = jnp.arange(start, end)[:, None]
        kpos = jnp.arange(end)[None, :]
        mask = kpos < qpos
        log_keep = jnp.where(mask, jax.nn.log_sigmoid(-z), 0.0)
        log_between = lax.cumsum(log_keep, axis=3, reverse=True) - log_keep
        w = jnp.where(mask, jnp.exp(jax.nn.log_sigmoid(z) + log_between), 0.0)
        outs.append(jnp.einsum('bhqk,bhkd->bhqd', w.astype(v.dtype), v[:, :, :end]))
    return jnp.concatenate(outs, axis=2)


def differential_attention(q, k, v, lam):
    seq_len = q.shape[3]
    scale = HEAD_DIM ** -0.5
    outs = []
    for i in range(seq_len // Q_BLOCK):
        start, end = i * Q_BLOCK, (i + 1) * Q_BLOCK
        s = jnp.einsum('bhcqd,bhckd->bhcqk', q[:, :, :, start:end], k[:, :, :, :end]).astype(jnp.float32) * scale
        qchunk = jnp.arange(start, end)[:, None] // CHUNK
        kchunk = jnp.arange(end)[None, :] // CHUNK
        s = jnp.where(kchunk <= qchunk, s, -jnp.inf)
        p = jax.nn.softmax(s, axis=-1)
        a = p[:, :, 0] - lam * p[:, :, 1]
        outs.append(jnp.einsum('bhqk,bhkv->bhqv', a.astype(v.dtype), v[:, :, :end]))
    return jnp.concatenate(outs, axis=2)


def setup_inputs(seed: int = 0) -> dict:
    key = jax.random.key(seed)
    ks = jax.random.split(key, 16)
    nrm = jax.random.normal
    f32 = jnp.float32
    return {
        "x": nrm(ks[0], (BATCH, SEQ, D_MODEL), f32),
        "g_mix": 1.0 + 0.02 * nrm(ks[1], (DEPTH, D_MODEL), f32),
        "w_in": nrm(ks[2], (DEPTH, D_MODEL, IN_WIDTH), f32) * D_MODEL ** -0.5,
        "lambda_q1": 0.1 * nrm(ks[3], (DEPTH, HEAD_DIM), f32),
        "lambda_k1": 0.1 * nrm(ks[4], (DEPTH, HEAD_DIM), f32),
        "lambda_q2": 0.1 * nrm(ks[5], (DEPTH, HEAD_DIM), f32),
        "lambda_k2": 0.1 * nrm(ks[6], (DEPTH, HEAD_DIM), f32),
        "g_subln": 1.0 + 0.02 * nrm(ks[7], (DEPTH, DA_V_DIM), f32),
        "w_branch_sb": nrm(ks[8], (DEPTH, SB_WIDTH, D_MODEL), f32) * SB_WIDTH ** -0.5,
        "w_branch_da": nrm(ks[9], (DEPTH, DA_V_WIDTH, D_MODEL), f32) * DA_V_WIDTH ** -0.5,
        "w_out": nrm(ks[10], (DEPTH, D_MODEL, D_MODEL), f32) * D_MODEL ** -0.5,
        "g_ffn": 1.0 + 0.02 * nrm(ks[11], (DEPTH, D_MODEL), f32),
        "w_ffn_gate": nrm(ks[12], (DEPTH, D_MODEL, D_FF), f32) * D_MODEL ** -0.5,
        "w_ffn_up": nrm(ks[13], (DEPTH, D_MODEL, D_FF), f32) * D_MODEL ** -0.5,
        "w_ffn_down": nrm(ks[14], (DEPTH, D_FF, D_MODEL), f32) * D_FF ** -0.5,
        "g_final": 1.0 + 0.02 * nrm(ks[15], (D_MODEL,), f32),
    }


def reference(x, g_mix, w_in, lambda_q1, lambda_k1, lambda_q2, lambda_k2, g_subln,
              w_branch_sb, w_branch_da, w_out, g_ffn, w_ffn_gate, w_ffn_up, w_ffn_down, g_final):
    B, S, _ = x.shape
    cos, sin = rope_tables(S)
    offsets = [int(o) for o in np.cumsum(IN_SPLITS)[:-1]]
    for l in range(DEPTH):
        lambda_init = 0.8 - 0.6 * math.exp(-0.3 * l)
        h = rms_norm(x, g_mix[l])
        proj = h @ w_in[l]
        qa, ka, va, qd, kd, vd, gates = jnp.split(proj, offsets, axis=-1)
        qa = qa.reshape(B, S, SB_HEADS, HEAD_DIM).transpose(0, 2, 1, 3)
        ka = ka.reshape(B, S, SB_HEADS, HEAD_DIM).transpose(0, 2, 1, 3)
        va = va.reshape(B, S, SB_HEADS, HEAD_DIM).transpose(0, 2, 1, 3)
        o_sb = stick_breaking_attention(qa, ka, va).transpose(0, 2, 1, 3).reshape(B, S, SB_WIDTH)
        qd = apply_rope(qd.reshape(B, S, 2 * DA_HEADS, HEAD_DIM), cos, sin)
        kd = apply_rope(kd.reshape(B, S, 2 * DA_HEADS, HEAD_DIM), cos, sin)
        qd = qd.reshape(B, S, DA_HEADS, 2, HEAD_DIM).transpose(0, 2, 3, 1, 4)
        kd = kd.reshape(B, S, DA_HEADS, 2, HEAD_DIM).transpose(0, 2, 3, 1, 4)
        vd = vd.reshape(B, S, DA_HEADS, DA_V_DIM).transpose(0, 2, 1, 3)
        lam = (jnp.exp(jnp.sum(lambda_q1[l].astype(jnp.float32) * lambda_k1[l].astype(jnp.float32)))
               - jnp.exp(jnp.sum(lambda_q2[l].astype(jnp.float32) * lambda_k2[l].astype(jnp.float32)))
               + lambda_init)
        o_da = differential_attention(qd, kd, vd, lam)
        o_da = rms_norm(o_da, g_subln[l], SUBLN_EPS) * (1.0 - lambda_init)
        o_da = o_da.transpose(0, 2, 1, 3).reshape(B, S, DA_V_WIDTH)
        gate_sb, gate_da = jnp.split(gates, N_BRANCH, axis=-1)
        mixed = (jax.nn.sigmoid(gate_sb) * (o_sb @ w_branch_sb[l])
                 + jax.nn.sigmoid(gate_da) * (o_da @ w_branch_da[l]))
        x = x + mixed @ w_out[l]
        h = rms_norm(x, g_ffn[l])
        x = x + (jax.nn.silu(h @ w_ffn_gate[l]) * (h @ w_ffn_up[l])) @ w_ffn_down[l]
    return rms_norm(x, g_final)
```

```cpp
#include <hip/hip_runtime.h>
#include <hip/hip_cooperative_groups.h>
#include <cstdio>
#include <cstdint>
namespace cg = cooperative_groups;
namespace pg8 {
#define PG8_LAS __attribute__((address_space(3)))
typedef unsigned short bf16_t;
typedef short bf16x8 __attribute__((ext_vector_type(8)));
typedef float f32x4 __attribute__((ext_vector_type(4)));
typedef unsigned u32x4 __attribute__((ext_vector_type(4)));
constexpr int BM = 256, BK = 64, HALF = 128, HTB = HALF * BK * 2  , STAGE_BYTES = 8 * HTB, NXCD = 8, WGM = 8;

__host__ __device__ __forceinline__ int lds_byte(int r, int c) { const int st = (r >> 4) * 2 + (c >> 5), rr = r & 15, cc = c & 31, ob = rr * 64 + cc * 2; return st * 1024 + (ob ^ (((ob >> 9) & 1) << 5)); }
__host__ __device__ __forceinline__ void stage_rc(int b, int& R, int& C) { const int st = b / 1024, sb = b % 1024, swz = sb ^ (((sb >> 9) & 1) << 5); R = (st >> 1) * 16 + swz / 64; C = (st & 1) * 32 + (swz % 64) / 2; }
__host__ __device__ __forceinline__ int perm32(int rho) { const int n = rho >> 4, i = rho & 15; return 8 * (i >> 2) + 4 * n + (i & 3); }

struct Unit { int pm, pn; };
struct Gemm { const bf16_t* A; const bf16_t* Bt; int M, N, K; };

struct StaticOrder {
    int nM, nN, nwg, G, c;
    __host__ __device__ void init(int M, int N, int G_, int c_) { nM = M / BM; nN = N / BM; nwg = nM * nN; G = G_; c = c_; }
    __host__ __device__ bool next(int i, Unit& u) const {
        const long L = (long)i * G + c; if (L >= nwg) return false;
        int wgid = (int)L; { const int q = nwg / NXCD, r = nwg % NXCD, xcd = wgid % NXCD, off = wgid / NXCD; wgid = (xcd < r ? xcd * (q + 1) : r * (q + 1) + (xcd - r) * q) + off; }
        const int nig = WGM * nN, gid = wgid / nig, fm = gid * WGM, gsz = (nM - fm) < WGM ? (nM - fm) : WGM;
        u.pm = fm + ((wgid % nig) % gsz); u.pn = (wgid % nig) / gsz; return true;
    }
    __device__ __forceinline__ void a_ready(const Unit&) const {}
    __device__ __forceinline__ void done(const Unit&) const {}
};

__device__ __forceinline__ unsigned cvt_pk_bf16(float lo, float hi) { typedef float f2 __attribute__((ext_vector_type(2))); typedef __bf16 b2 __attribute__((ext_vector_type(2))); f2 v = {lo, hi}; b2 b = __builtin_convertvector(v, b2); return __builtin_bit_cast(unsigned, b); }
__device__ __forceinline__ float bflo(unsigned w) { return __uint_as_float(w << 16); }
__device__ __forceinline__ float bfhi(unsigned w) { return __uint_as_float(w & 0xffff0000u); }
__device__ __forceinline__ float sigmoidf_(float x) { return __builtin_amdgcn_rcpf(1.0f + __builtin_amdgcn_exp2f(-1.4426950408889634f * x)); }
constexpr float QSCALE = 0.125f * 1.4426950408889634f;

struct EpiProj {
    static constexpr bool PERM = true, AFTER_DRAIN = false;
    bf16_t* O; const float* rc; const float* rs;
    __device__ __forceinline__ void operator()(const f32x4 (&acc)[2][2][4][2], const Unit& u, int wr, int wc, int fr, int fq) const {
        const int pn = u.pn; const bool rope = (pn >= 6 && pn < 10); const float sc = (pn < 2 || pn == 6 || pn == 7) ? QSCALE : 1.0f;
#pragma unroll
        for (int ai = 0; ai < 2; ++ai)
#pragma unroll
            for (int m = 0; m < 4; ++m) { const int row = u.pm * BM + ai * HALF + wr * 64 + m * 16 + fr; const int pos = row & 4095;
#pragma unroll
                for (int bj = 0; bj < 2; ++bj) { const int col0 = pn * BM + bj * HALF + wc * 32 + 8 * fq;
                    f32x4 v0 = acc[ai][bj][m][0], v1 = acc[ai][bj][m][1];
                    if (rope) { const int i0 = (col0 & 63) >> 1; const f32x4 c4 = *(const f32x4*)(rc + pos * 32 + i0), s4 = *(const f32x4*)(rs + pos * 32 + i0);
                        float a, b;
                        a = v0[0]; b = v0[1]; v0[0] = a * c4[0] - b * s4[0]; v0[1] = b * c4[0] + a * s4[0];
                        a = v0[2]; b = v0[3]; v0[2] = a * c4[1] - b * s4[1]; v0[3] = b * c4[1] + a * s4[1];
                        a = v1[0]; b = v1[1]; v1[0] = a * c4[2] - b * s4[2]; v1[1] = b * c4[2] + a * s4[2];
                        a = v1[2]; b = v1[3]; v1[2] = a * c4[3] - b * s4[3]; v1[3] = b * c4[3] + a * s4[3]; }
                    v0 = v0 * sc; v1 = v1 * sc;
                    u32x4 w; w.x = cvt_pk_bf16(v0[0], v0[1]); w.y = cvt_pk_bf16(v0[2], v0[3]); w.z = cvt_pk_bf16(v1[0], v1[1]); w.w = cvt_pk_bf16(v1[2], v1[3]);
                    *(u32x4*)(O + (size_t)row * 5120 + col0) = w; } }
    }
};
struct EpiGate {
    static constexpr bool PERM = true, AFTER_DRAIN = false;
    const bf16_t* P; bf16_t* Mx;
    __device__ __forceinline__ void operator()(const f32x4 (&acc)[2][2][4][2], const Unit& u, int wr, int wc, int fr, int fq) const {
        const int br = u.pm >> 8, pm = u.pm & 255, pn = u.pn & 3;
#pragma unroll
        for (int ai = 0; ai < 2; ++ai)
#pragma unroll
            for (int m = 0; m < 4; ++m) { const int row = pm * BM + ai * HALF + wr * 64 + m * 16 + fr;
#pragma unroll
                for (int bj = 0; bj < 2; ++bj) { const int col0 = pn * BM + bj * HALF + wc * 32 + 8 * fq;
                    const u32x4 g = *(const u32x4*)(P + (size_t)row * 5120 + 3072 + 1024 * br + col0);
                    f32x4 v0 = acc[ai][bj][m][0], v1 = acc[ai][bj][m][1];
                    v0[0] *= sigmoidf_(bflo(g.x)); v0[1] *= sigmoidf_(bfhi(g.x)); v0[2] *= sigmoidf_(bflo(g.y)); v0[3] *= sigmoidf_(bfhi(g.y));
                    v1[0] *= sigmoidf_(bflo(g.z)); v1[1] *= sigmoidf_(bfhi(g.z)); v1[2] *= sigmoidf_(bflo(g.w)); v1[3] *= sigmoidf_(bfhi(g.w));
                    bf16_t* dst = Mx + (size_t)row * 1024 + col0;
                    if (br) { const u32x4 p = *(const u32x4*)dst;
                        v0[0] += bflo(p.x); v0[1] += bfhi(p.x); v0[2] += bflo(p.y); v0[3] += bfhi(p.y); v1[0] += bflo(p.z); v1[1] += bfhi(p.z); v1[2] += bflo(p.w); v1[3] += bfhi(p.w); }
                    u32x4 w; w.x = cvt_pk_bf16(v0[0], v0[1]); w.y = cvt_pk_bf16(v0[2], v0[3]); w.z = cvt_pk_bf16(v1[0], v1[1]); w.w = cvt_pk_bf16(v1[2], v1[3]);
                    *(u32x4*)dst = w; } }
    }
};
struct EpiOut {
    static constexpr bool PERM = true, AFTER_DRAIN = false;
    const float* X; float* Out; bf16_t* Xb; float* rowss;
    __device__ __forceinline__ void operator()(const f32x4 (&acc)[2][2][4][2], const Unit& u, int wr, int wc, int fr, int fq) const {
#pragma unroll
        for (int ai = 0; ai < 2; ++ai)
#pragma unroll
            for (int m = 0; m < 4; ++m) { const int row = u.pm * BM + ai * HALF + wr * 64 + m * 16 + fr; float ss = 0.f;
#pragma unroll
                for (int bj = 0; bj < 2; ++bj) { const int col0 = u.pn * BM + bj * HALF + wc * 32 + 8 * fq; const size_t off = (size_t)row * 1024 + col0;
                    const f32x4 v0 = acc[ai][bj][m][0] + *(const f32x4*)(X + off), v1 = acc[ai][bj][m][1] + *(const f32x4*)(X + off + 4);
                    *(f32x4*)(Out + off) = v0; *(f32x4*)(Out + off + 4) = v1;
                    ss += (v0[0] * v0[0] + v0[1] * v0[1]) + (v0[2] * v0[2] + v0[3] * v0[3]) + (v1[0] * v1[0] + v1[1] * v1[1]) + (v1[2] * v1[2] + v1[3] * v1[3]);
                    u32x4 w; w.x = cvt_pk_bf16(v0[0], v0[1]); w.y = cvt_pk_bf16(v0[2], v0[3]); w.z = cvt_pk_bf16(v1[0], v1[1]); w.w = cvt_pk_bf16(v1[2], v1[3]);
                    *(u32x4*)(Xb + off) = w; }
                ss += __shfl_xor(ss, 16); ss += __shfl_xor(ss, 32);
                if (fq == 0) unsafeAtomicAdd(rowss + row, ss); }
    }
};
struct EpiSwiGlu {
    static constexpr bool PERM = true, AFTER_DRAIN = false;
    bf16_t* U; const float* rowss;
    __device__ __forceinline__ void operator()(const f32x4 (&acc)[2][2][4][2], const Unit& u, int wr, int wc, int fr, int fq) const {
#pragma unroll
        for (int ai = 0; ai < 2; ++ai)
#pragma unroll
            for (int m = 0; m < 4; ++m) { const int row = u.pm * BM + ai * HALF + wr * 64 + m * 16 + fr;
                const float rsd = 1.0f / sqrtf(rowss[row] * (1.0f / 1024.0f) + 1e-6f);
                const int col0 = u.pn * HALF + wc * 32 + 8 * fq;
                f32x4 o0, o1;
#pragma unroll
                for (int j = 0; j < 4; ++j) { const float g0 = acc[ai][0][m][0][j] * rsd, u0 = acc[ai][1][m][0][j] * rsd, g1 = acc[ai][0][m][1][j] * rsd, u1 = acc[ai][1][m][1][j] * rsd;
                    o0[j] = g0 * sigmoidf_(g0) * u0; o1[j] = g1 * sigmoidf_(g1) * u1; }
                u32x4 w; w.x = cvt_pk_bf16(o0[0], o0[1]); w.y = cvt_pk_bf16(o0[2], o0[3]); w.z = cvt_pk_bf16(o1[0], o1[1]); w.w = cvt_pk_bf16(o1[2], o1[3]);
                *(u32x4*)(U + (size_t)row * 2816 + col0) = w; }
    }
};
struct EpiDown {
    static constexpr bool PERM = true, AFTER_DRAIN = false;
    float* Out;
    __device__ __forceinline__ void operator()(const f32x4 (&acc)[2][2][4][2], const Unit& u, int wr, int wc, int fr, int fq) const {
#pragma unroll
        for (int ai = 0; ai < 2; ++ai)
#pragma unroll
            for (int m = 0; m < 4; ++m) { const int row = u.pm * BM + ai * HALF + wr * 64 + m * 16 + fr;
#pragma unroll
                for (int bj = 0; bj < 2; ++bj) { const int col0 = u.pn * BM + bj * HALF + wc * 32 + 8 * fq; float* p = Out + (size_t)row * 1024 + col0;
                    const f32x4 v0 = acc[ai][bj][m][0] + *(const f32x4*)p, v1 = acc[ai][bj][m][1] + *(const f32x4*)(p + 4);
                    *(f32x4*)p = v0; *(f32x4*)(p + 4) = v1; } }
    }
};
struct BranchOrder {
    StaticOrder base;
    __host__ __device__ void init(int M, int N, int G_, int c_) { base.init(M, N, G_, c_); }
    __host__ __device__ bool next(int i, Unit& u) const { Unit t; if (!base.next(i >> 1, t)) return false; const int br = i & 1; u.pm = t.pm + 256 * br; u.pn = t.pn + 4 * br; return true; }
    __device__ __forceinline__ void a_ready(const Unit&) const {}
    __device__ __forceinline__ void done(const Unit&) const {}
};
template <class Epi, class Sched, bool ALIGN_EPI = false, bool SP2 = false>
__device__ __forceinline__ void gemm_phase(PG8_LAS unsigned char* lds, const Gemm g, const Sched& S, const Epi& E) {
    const int tid = threadIdx.x, wid = __builtin_amdgcn_readfirstlane(tid >> 6), lane = tid & 63, wr = wid >> 2, wc = wid & 3, fr = lane & 15, fq = lane >> 4;
    const int K = g.K, nt = K / BK;
    unsigned voffA[2], voffB[2];
#pragma unroll
    for (int i = 0; i < 2; ++i) { int R, C; stage_rc(tid * 16 + i * 8192, R, C); const int Rb = Epi::PERM ? ((R & ~31) + perm32(R & 31)) : R;
        voffA[i] = (unsigned)(R * K + C) * 2u; voffB[i] = (unsigned)(Rb * K + C) * 2u; }
    const size_t kstep = (size_t)(BK * 2);
    const size_t hstep = (size_t)HALF * K * 2;
    const size_t tstep = 2 * hstep;
    const unsigned ldsw = (unsigned)wid * 1024u;
    const int aoff = lds_byte(wr * 64 + fr, fq * 8), boff = lds_byte(wc * 32 + fr, fq * 8);
#define PG8_SA(b, h) (((b) * 2 + (h)) * HTB)
#define PG8_SB(b, h) ((4 + (b) * 2 + (h)) * HTB)
#define PG8_STAGE(bufoff, gbase, voff) do { _Pragma("unroll") for (int _i = 0; _i < 2; ++_i) \
        __builtin_amdgcn_global_load_lds((const unsigned*)((const char*)(gbase) + (voff)[_i]), (PG8_LAS unsigned*)(lds + (bufoff) + ldsw + _i * 8192), 16, 0, 0); } while (0)
#define PG8_LDA(dst, b, h) do { _Pragma("unroll") for (int m = 0; m < 4; ++m) _Pragma("unroll") for (int k = 0; k < 2; ++k) dst[m][k] = *(const PG8_LAS bf16x8*)(lds + PG8_SA(b, h) + aoff + m * 2048 + k * 1024); } while (0)
#define PG8_LDB(dst, b, h) do { _Pragma("unroll") for (int n = 0; n < 2; ++n) _Pragma("unroll") for (int k = 0; k < 2; ++k) dst[n][k] = *(const PG8_LAS bf16x8*)(lds + PG8_SB(b, h) + boff + n * 2048 + k * 1024); } while (0)
#define PG8_MMA(ai, bj, At, Bt) do { __builtin_amdgcn_s_setprio(1); _Pragma("unroll") for (int m = 0; m < 4; ++m) _Pragma("unroll") for (int n = 0; n < 2; ++n) _Pragma("unroll") for (int k = 0; k < 2; ++k) \
        acc[ai][bj][m][n] = __builtin_amdgcn_mfma_f32_16x16x32_bf16(Bt[n][k], At[m][k], acc[ai][bj][m][n], 0, 0, 0); __builtin_amdgcn_s_setprio(0); } while (0)
#define PG8_WAIT_V(n) asm volatile("s_waitcnt vmcnt(" #n ")" ::: "memory")
#define PG8_WAIT_L(n) asm volatile("s_waitcnt lgkmcnt(" #n ")" ::: "memory")
#define PG8_BAR __builtin_amdgcn_s_barrier()
#define PG8_SCHED __builtin_amdgcn_sched_barrier(0)
    Unit cur, nxt; int ui = 0;
    if (!S.next(0, cur)) return;
    f32x4 acc[2][2][4][2];
#pragma unroll
    for (int a = 0; a < 2; ++a)
#pragma unroll
        for (int b = 0; b < 2; ++b)
#pragma unroll
            for (int m = 0; m < 4; ++m)
#pragma unroll
                for (int n = 0; n < 2; ++n) acc[a][b][m][n] = (f32x4){0.f, 0.f, 0.f, 0.f};
    bf16x8 At[4][2], B0[2][2], B1[2][2];
    const char* cA = (const char*)g.A + (size_t)cur.pm * tstep; const char* cB = (const char*)g.Bt + (size_t)cur.pn * tstep;
    S.a_ready(cur);
    if constexpr (SP2) {
        PG8_STAGE(PG8_SB(0, 0), cB, voffB); PG8_STAGE(PG8_SB(0, 1), cB + hstep, voffB); PG8_STAGE(PG8_SA(0, 0), cA, voffA); PG8_STAGE(PG8_SA(0, 1), cA + hstep, voffA);
        if (wr == 1) PG8_BAR;
        PG8_WAIT_V(2); PG8_BAR;
        PG8_STAGE(PG8_SB(1, 0), cB + kstep, voffB); PG8_STAGE(PG8_SA(1, 0), cA + kstep, voffA); PG8_STAGE(PG8_SB(1, 1), cB + hstep + kstep, voffB);
        PG8_WAIT_V(6); PG8_BAR;
    } else {
        PG8_STAGE(PG8_SB(0, 0), cB, voffB); PG8_STAGE(PG8_SA(0, 0), cA, voffA); PG8_STAGE(PG8_SB(0, 1), cB + hstep, voffB); PG8_STAGE(PG8_SA(0, 1), cA + hstep, voffA);
        if (wr == 1) PG8_BAR;
        PG8_WAIT_V(4); PG8_BAR;
        PG8_STAGE(PG8_SB(1, 0), cB + kstep, voffB); PG8_STAGE(PG8_SA(1, 0), cA + kstep, voffA); PG8_STAGE(PG8_SB(1, 1), cB + hstep + kstep, voffB);
        PG8_WAIT_V(6); PG8_BAR;
    }
    for (;;) {
        const bool has_next = S.next(ui + 1, nxt);
        const char* nA = has_next ? (const char*)g.A + (size_t)nxt.pm * tstep : cA; const char* nB = has_next ? (const char*)g.Bt + (size_t)nxt.pn * tstep : cB;
        for (int t = 0; t < nt; t += 2) {
            const bool last = (t == nt - 2);
            const char* a1 = cA + (size_t)(t + 1) * kstep;
            const char* a2 = last ? nA : cA + (size_t)(t + 2) * kstep; const char* b2 = last ? nB : cB + (size_t)(t + 2) * kstep;
            const char* a3 = a2 + kstep; const char* b3 = b2 + kstep;
            if (last && has_next) S.a_ready(nxt);
            if constexpr (SP2) {
            PG8_LDB(B0, 0, 0); PG8_LDB(B1, 0, 1); PG8_SCHED; PG8_LDA(At, 0, 0); PG8_STAGE(PG8_SA(1, 1), a1 + hstep, voffA);
            PG8_WAIT_V(8); PG8_WAIT_L(0); PG8_BAR; PG8_MMA(0, 0, At, B0); PG8_MMA(0, 1, At, B1); PG8_BAR; PG8_SCHED;
            PG8_LDA(At, 0, 1); PG8_STAGE(PG8_SB(0, 0), b2, voffB); PG8_STAGE(PG8_SB(0, 1), b2 + hstep, voffB); PG8_STAGE(PG8_SA(0, 0), a2, voffA);
            PG8_WAIT_V(8); PG8_WAIT_L(0); PG8_BAR; PG8_MMA(1, 0, At, B0); PG8_MMA(1, 1, At, B1); PG8_BAR; PG8_SCHED;
            PG8_LDB(B0, 1, 0); PG8_LDB(B1, 1, 1); PG8_SCHED; PG8_LDA(At, 1, 0); PG8_STAGE(PG8_SA(0, 1), a2 + hstep, voffA);
            PG8_WAIT_V(8); PG8_WAIT_L(0); PG8_BAR; PG8_MMA(0, 0, At, B0); PG8_MMA(0, 1, At, B1); PG8_BAR; PG8_SCHED;
            PG8_LDA(At, 1, 1); PG8_STAGE(PG8_SB(1, 0), b3, voffB); PG8_STAGE(PG8_SB(1, 1), b3 + hstep, voffB); PG8_STAGE(PG8_SA(1, 0), a3, voffA);
            PG8_WAIT_V(8); PG8_WAIT_L(0); PG8_BAR; PG8_MMA(1, 0, At, B0); PG8_MMA(1, 1, At, B1); PG8_BAR; PG8_SCHED;
            } else {
            PG8_LDB(B0, 0, 0); PG8_SCHED; PG8_LDA(At, 0, 0); PG8_STAGE(PG8_SA(1, 1), a1 + hstep, voffA);
            PG8_WAIT_L(8); PG8_BAR; PG8_WAIT_L(0); PG8_MMA(0, 0, At, B0); PG8_BAR; PG8_SCHED;
            PG8_LDB(B1, 0, 1); PG8_STAGE(PG8_SB(0, 0), b2, voffB);
            PG8_BAR; PG8_WAIT_L(0); PG8_MMA(0, 1, At, B1); PG8_BAR;
            PG8_LDA(At, 0, 1); PG8_STAGE(PG8_SA(0, 0), a2, voffA);
            PG8_BAR; PG8_WAIT_L(0); PG8_MMA(1, 0, At, B0); PG8_BAR; PG8_SCHED;
            PG8_STAGE(PG8_SB(0, 1), b2 + hstep, voffB);
            PG8_WAIT_V(6); PG8_BAR; PG8_MMA(1, 1, At, B1); PG8_BAR;
            PG8_LDB(B0, 1, 0); PG8_SCHED; PG8_LDA(At, 1, 0); PG8_STAGE(PG8_SA(0, 1), a2 + hstep, voffA);
            PG8_WAIT_L(8); PG8_BAR; PG8_WAIT_L(0); PG8_MMA(0, 0, At, B0); PG8_BAR; PG8_SCHED;
            PG8_LDB(B1, 1, 1); PG8_STAGE(PG8_SB(1, 0), b3, voffB);
            PG8_BAR; PG8_WAIT_L(0); PG8_MMA(0, 1, At, B1); PG8_BAR;
            PG8_LDA(At, 1, 1); PG8_STAGE(PG8_SA(1, 0), a3, voffA);
            PG8_BAR; PG8_WAIT_L(0); PG8_MMA(1, 0, At, B0); PG8_BAR; PG8_SCHED;
            PG8_STAGE(PG8_SB(1, 1), b3 + hstep, voffB);
            PG8_WAIT_V(6); PG8_BAR; PG8_MMA(1, 1, At, B1); PG8_BAR;
            }
        }
        if constexpr (ALIGN_EPI) { if (wr == 0) PG8_BAR; }
        if constexpr (!Epi::AFTER_DRAIN) { E(acc, cur, wr, wc, fr, fq); S.done(cur); }
        if (!has_next) break;
#pragma unroll
        for (int a = 0; a < 2; ++a)
#pragma unroll
            for (int b = 0; b < 2; ++b)
#pragma unroll
                for (int m = 0; m < 4; ++m)
#pragma unroll
                    for (int n = 0; n < 2; ++n) acc[a][b][m][n] = (f32x4){0.f, 0.f, 0.f, 0.f};
        cur = nxt; cA = nA; cB = nB; ++ui;
        if constexpr (ALIGN_EPI) { if (wr == 1) PG8_BAR; }
    }
    PG8_WAIT_V(0);
    if constexpr (!ALIGN_EPI) { if (wr == 0) PG8_BAR; }
    PG8_BAR;
    if constexpr (Epi::AFTER_DRAIN) { E.fused(acc, cur, wr, wc, fr, fq, lds, wid, lane); S.done(cur); }
#undef PG8_SA
#undef PG8_SB
#undef PG8_STAGE
#undef PG8_LDA
#undef PG8_LDB
#undef PG8_MMA
#undef PG8_WAIT_V
#undef PG8_WAIT_L
#undef PG8_BAR
#undef PG8_SCHED
}
}
namespace att {
typedef unsigned short bf16_t;
typedef short bf16x8 __attribute__((ext_vector_type(8)));
typedef short s16x4 __attribute__((ext_vector_type(4)));
typedef float f32x16 __attribute__((ext_vector_type(16)));
typedef unsigned u32x4 __attribute__((ext_vector_type(4)));
typedef float f32x4 __attribute__((ext_vector_type(4)));
#define ALAS __attribute__((address_space(3)))
constexpr int PITCH = 5120, SEQ = 4096;
constexpr int KP = 272, VP = 320, KBUF = 64 * KP, VBUF = 64 * VP, STG = KBUF + VBUF;
constexpr int OFF_WSF = 2 * STG, OFF_FLAG = OFF_WSF + 8 * 64 * 4, ATT_LDS = OFF_FLAG + 64;
constexpr int CBP = 132;
static_assert(128 * CBP * 4 <= OFF_WSF, "combine buffer fits under the scratch");
constexpr float SB_DONE = -160.0f;

__device__ __forceinline__ int crow(int r, int hi) { return (r & 3) + 8 * (r >> 2) + 4 * hi; }
__device__ __forceinline__ unsigned cvtpk(float lo, float hi) { typedef float f2 __attribute__((ext_vector_type(2))); typedef __bf16 b2 __attribute__((ext_vector_type(2))); f2 v = {lo, hi}; b2 b = __builtin_convertvector(v, b2); return __builtin_bit_cast(unsigned, b); }
__device__ __forceinline__ float other_half(float v, int hi) { auto rr = __builtin_amdgcn_permlane32_swap(__float_as_uint(v), __float_as_uint(v), false, false); return __uint_as_float(hi ? rr[0] : rr[1]); }
#define MFMA32(a, b, c) __builtin_amdgcn_mfma_f32_32x32x16_bf16((a), (b), (c), 0, 0, 0)

struct TileRegs { u32x4 k0, k1, v0, v1; };
__device__ __forceinline__ void tile_load(TileRegs& R, const bf16_t* kbase, const bf16_t* vbase, int kv0, int tid) {
    const int row = tid >> 4, ch = tid & 15;
    const bf16_t* kp = kbase + (size_t)(kv0 + row) * PITCH + ch * 8; const bf16_t* vp = vbase + (size_t)(kv0 + row) * PITCH + ch * 8;
    R.k0 = *(const u32x4*)kp; R.k1 = *(const u32x4*)(kp + 32 * PITCH); R.v0 = *(const u32x4*)vp; R.v1 = *(const u32x4*)(vp + 32 * PITCH);
}
__device__ __forceinline__ void tile_store(ALAS unsigned char* stg, const TileRegs& R, int tid) {
    const int row = tid >> 4, ch = tid & 15;
    *(ALAS u32x4*)(stg + row * KP + ch * 16) = R.k0; *(ALAS u32x4*)(stg + (row + 32) * KP + ch * 16) = R.k1;
    *(ALAS u32x4*)(stg + KBUF + row * VP + ch * 16) = R.v0; *(ALAS u32x4*)(stg + KBUF + (row + 32) * VP + ch * 16) = R.v1;
}
__device__ __forceinline__ void qk_tile(f32x16& s0, f32x16& s1, const ALAS unsigned char* kb, const bf16x8* qr, int r32, int hi) {
    const ALAS unsigned char* p = kb + r32 * KP + hi * 16;
#pragma unroll
    for (int i = 0; i < 16; ++i) { s0[i] = 0.f; s1[i] = 0.f; }
#pragma unroll
    for (int d0 = 0; d0 < 4; ++d0) {
        const bf16x8 a0 = *(const ALAS bf16x8*)(p + d0 * 32), a1 = *(const ALAS bf16x8*)(p + 32 * KP + d0 * 32);
        s0 = MFMA32(a0, qr[d0], s0); s1 = MFMA32(a1, qr[d0], s1); }
}
__device__ __forceinline__ bf16x8 pack8(const f32x16& x, const int s) {
    u32x4 p; p[0] = cvtpk(x[8 * s], x[8 * s + 1]); p[1] = cvtpk(x[8 * s + 2], x[8 * s + 3]); p[2] = cvtpk(x[8 * s + 4], x[8 * s + 5]); p[3] = cvtpk(x[8 * s + 6], x[8 * s + 7]);
    return __builtin_bit_cast(bf16x8, p);
}
typedef short v4i16_t __attribute__((ext_vector_type(4)));
__device__ __forceinline__ s16x4 vtr(const ALAS unsigned char* p) { return __builtin_bit_cast(s16x4, __builtin_amdgcn_ds_read_tr16_b64_v4i16((ALAS v4i16_t*)p)); }
template <int NDB> __device__ __forceinline__ void pv_tile(f32x16* o, const ALAS unsigned char* vb, const bf16x8 (&pa)[2][2], int lane) {
    const int i16 = lane & 15, q4 = i16 >> 2, p = i16 & 3, blk = (lane >> 4) & 1, hi = lane >> 5;
    const ALAS unsigned char* base = vb + (4 * hi + q4) * VP + blk * 32 + p * 8;
#pragma unroll
    for (int db = 0; db < NDB; ++db)
#pragma unroll
        for (int half = 0; half < 2; ++half)
#pragma unroll
            for (int s = 0; s < 2; ++s) {
                const s16x4 lo = vtr(base + (half * 32 + 16 * s) * VP + db * 64), hh = vtr(base + (half * 32 + 16 * s + 8) * VP + db * 64);
                const bf16x8 vf = __builtin_shufflevector(lo, hh, 0, 1, 2, 3, 4, 5, 6, 7);
                o[db] = MFMA32(pa[half][s], vf, o[db]); }
}
__device__ __forceinline__ void sb_half(const f32x16& z, f32x16& w, float& tot, float base, bool diag, int kv0, int qabs, int hi) {
    float lk[16], lb[16];
#pragma unroll
    for (int i = 0; i < 16; ++i) { const bool valid = !diag || (kv0 + crow(i, hi) < qabs);
        const float zz = z[i]; const float e = __builtin_amdgcn_exp2f(-__builtin_fabsf(zz)); const float sp = __builtin_fmaxf(zz, 0.f) + __builtin_amdgcn_logf(1.0f + e);
        lk[i] = valid ? -sp : 0.f; lb[i] = zz - sp; }
    float G[4], PG[4], T[4], ST[4];
#pragma unroll
    for (int g = 0; g < 4; ++g) { G[g] = (lk[4 * g] + lk[4 * g + 1]) + (lk[4 * g + 2] + lk[4 * g + 3]); PG[g] = other_half(G[g], hi); T[g] = G[g] + PG[g]; }
    ST[3] = 0.f; ST[2] = T[3]; ST[1] = ST[2] + T[2]; ST[0] = ST[1] + T[1]; tot = ST[0] + T[0];
#pragma unroll
    for (int g = 0; g < 4; ++g) { float b = base + ST[g] + (hi == 0 ? PG[g] : 0.f);
#pragma unroll
        for (int j = 3; j >= 0; --j) { const int i = 4 * g + j; const bool valid = !diag || (kv0 + crow(i, hi) < qabs);
            w[i] = valid ? __builtin_amdgcn_exp2f(lb[i] + b) : 0.f; b += lk[i]; } }
}
__device__ __forceinline__ void sb_unit(ALAS unsigned char* lds, const bf16_t* PROJ, bf16_t* Osb, int b, int hp, int qb) {
    const int tid = threadIdx.x, lane = tid & 63, r32 = lane & 31, hi = lane >> 5; const int wid = __builtin_amdgcn_readfirstlane(tid >> 6);
    const int c = wid >> 2, qs = wid & 3; const int tokbase = b * SEQ, q0 = qb * 128, qw0 = q0 + 32 * qs, qabs = qw0 + r32;
    const bf16_t* kbase = PROJ + (size_t)tokbase * PITCH + 512 + 128 * hp; const bf16_t* vbase = PROJ + (size_t)tokbase * PITCH + 1024 + 128 * hp;
    bf16x8 qr[4];
#pragma unroll
    for (int d0 = 0; d0 < 4; ++d0) qr[d0] = *(const bf16x8*)(PROJ + (size_t)(tokbase + qw0 + r32) * PITCH + 128 * hp + 64 * c + 16 * d0 + 8 * hi);
    const int T0 = (q0 >> 6) + 1, td = qw0 >> 6;
    f32x16 o[2];
#pragma unroll
    for (int i = 0; i < 16; ++i) { o[0][i] = 0.f; o[1][i] = 0.f; }
    float carry = 0.f; bool done = false;
    ALAS int* flag = (ALAS int*)(lds + OFF_FLAG);
    TileRegs R; tile_load(R, kbase, vbase, T0 * 64, tid); tile_store(lds, R, tid); __syncthreads();
    int it = 0;
    for (int t = T0;; --t, ++it) {
        const ALAS unsigned char* cur = lds + (it & 1) * STG; ALAS unsigned char* nxt = lds + ((it + 1) & 1) * STG;
        const bool has_next = t > 0;
        if (has_next) tile_load(R, kbase, vbase, (t - 1) * 64, tid);
        if (!done && t <= td) {
            f32x16 z0, z1; qk_tile(z0, z1, cur + c * 128, qr, r32, hi);
            const bool diag = (t == td); const int kvb = t * 64;
            f32x16 w0, w1; float tot1, tot0;
            sb_half(z1, w1, tot1, carry, diag, kvb + 32, qabs, hi);
            sb_half(z0, w0, tot0, carry + tot1, diag, kvb, qabs, hi);
            carry += tot1 + tot0;
            bf16x8 pa[2][2]; pa[0][0] = pack8(w0, 0); pa[0][1] = pack8(w0, 1); pa[1][0] = pack8(w1, 0); pa[1][1] = pack8(w1, 1);
            pv_tile<2>(o, cur + KBUF + c * 128, pa, lane);
            done = __all(carry < SB_DONE);
        }
        if (lane == 0) flag[(it & 1) * 8 + wid] = done ? 1 : 0;
        if (has_next) tile_store(nxt, R, tid);
        __syncthreads();
        int alld = 1;
#pragma unroll
        for (int w = 0; w < 8; ++w) alld &= flag[(it & 1) * 8 + w];
        if (!has_next || alld) break;
    }
    ALAS unsigned char* st = lds + wid * (32 * 144);
#pragma unroll
    for (int db = 0; db < 2; ++db)
#pragma unroll
        for (int i = 0; i < 16; ++i) *(ALAS bf16_t*)(st + crow(i, hi) * 144 + (32 * db + r32) * 2) = (bf16_t)(cvtpk(o[db][i], 0.f) & 0xffffu);
    __builtin_amdgcn_fence(__ATOMIC_RELEASE, "wavefront"); asm volatile("s_waitcnt lgkmcnt(0)" ::: "memory");
#pragma unroll
    for (int j = 0; j < 4; ++j) { const int idx = j * 64 + lane, row = idx >> 3, ch = idx & 7; const u32x4 v = *(const ALAS u32x4*)(st + row * 144 + ch * 16);
        *(u32x4*)(Osb + (size_t)(tokbase + qw0 + row) * 512 + 64 * (2 * hp + c) + ch * 8) = v; }
    __syncthreads();
}
__device__ __forceinline__ void da_unit(ALAS unsigned char* lds, const bf16_t* PROJ, bf16_t* Oda, const float* gsub, float lam, int b, int hd, int qb) {
    const int tid = threadIdx.x, lane = tid & 63, r32 = lane & 31, hi = lane >> 5; const int wid = __builtin_amdgcn_readfirstlane(tid >> 6);
    const int c = wid >> 2, qs = wid & 3; const int tokbase = b * SEQ, q0 = qb * 128, qw0 = q0 + 32 * qs;
    const bf16_t* kbase = PROJ + (size_t)tokbase * PITCH + 2048 + 128 * hd; const bf16_t* vbase = PROJ + (size_t)tokbase * PITCH + 2560 + 128 * hd;
    bf16x8 qr[4];
#pragma unroll
    for (int d0 = 0; d0 < 4; ++d0) qr[d0] = *(const bf16x8*)(PROJ + (size_t)(tokbase + qw0 + r32) * PITCH + 1536 + 128 * hd + 64 * c + 16 * d0 + 8 * hi);
    const int NT = (q0 >> 6) + 2, ntw = (qw0 >> 6) + 1;
    f32x16 o[4];
#pragma unroll
    for (int db = 0; db < 4; ++db)
#pragma unroll
        for (int i = 0; i < 16; ++i) o[db][i] = 0.f;
    float m = -1e30f, l = 0.f;
    ALAS float* wsf = (ALAS float*)(lds + OFF_WSF) + wid * 64;
    TileRegs R; tile_load(R, kbase, vbase, 0, tid); tile_store(lds, R, tid); __syncthreads();
    for (int t = 0; t < NT; ++t) {
        const ALAS unsigned char* cur = lds + (t & 1) * STG; ALAS unsigned char* nxt = lds + ((t + 1) & 1) * STG;
        const bool has_next = t + 1 < NT;
        if (has_next) tile_load(R, kbase, vbase, (t + 1) * 64, tid);
        if (t < ntw) {
            f32x16 s0, s1; qk_tile(s0, s1, cur + c * 128, qr, r32, hi);
            float mx = __builtin_fmaxf(s0[0], s1[0]);
#pragma unroll
            for (int i = 1; i < 16; ++i) mx = __builtin_fmaxf(mx, __builtin_fmaxf(s0[i], s1[i]));
            mx = __builtin_fmaxf(mx, other_half(mx, hi));
            const float mnew = __builtin_fmaxf(m, mx);
            if (__any(mnew > m)) {
                const float f = __builtin_amdgcn_exp2f(m - mnew); l *= f; m = mnew;
                if (hi == 0) wsf[r32] = f;
                __builtin_amdgcn_fence(__ATOMIC_RELEASE, "wavefront"); asm volatile("s_waitcnt lgkmcnt(0)" ::: "memory");
#pragma unroll
                for (int i = 0; i < 16; ++i) { const float fi = wsf[crow(i, hi)];
#pragma unroll
                    for (int db = 0; db < 4; ++db) o[db][i] *= fi; }
            }
            float ls = 0.f;
#pragma unroll
            for (int i = 0; i < 16; ++i) { s0[i] = __builtin_amdgcn_exp2f(s0[i] - m); s1[i] = __builtin_amdgcn_exp2f(s1[i] - m); ls += s0[i] + s1[i]; }
            l += ls;
            bf16x8 pa[2][2]; pa[0][0] = pack8(s0, 0); pa[0][1] = pack8(s0, 1); pa[1][0] = pack8(s1, 0); pa[1][1] = pack8(s1, 1);
            pv_tile<4>(o, cur + KBUF, pa, lane);
        }
        if (has_next) tile_store(nxt, R, tid);
        __syncthreads();
    }
    { const float lt = l + other_half(l, hi); const float inv = (c ? lam : 1.0f) / lt;
      if (hi == 0) wsf[r32] = inv;
      __builtin_amdgcn_fence(__ATOMIC_RELEASE, "wavefront"); asm volatile("s_waitcnt lgkmcnt(0)" ::: "memory");
#pragma unroll
      for (int i = 0; i < 16; ++i) { const float fi = wsf[crow(i, hi)];
#pragma unroll
          for (int db = 0; db < 4; ++db) o[db][i] *= fi; } }
    ALAS float* CB = (ALAS float*)lds;
    if (c == 1) {
#pragma unroll
        for (int db = 0; db < 4; ++db)
#pragma unroll
            for (int i = 0; i < 16; ++i) CB[(32 * qs + crow(i, hi)) * CBP + 32 * db + r32] = o[db][i];
    }
    __syncthreads();
    if (c == 0) {
#pragma unroll
        for (int db = 0; db < 4; ++db)
#pragma unroll
            for (int i = 0; i < 16; ++i) { const int idx = (32 * qs + crow(i, hi)) * CBP + 32 * db + r32; CB[idx] = o[db][i] - CB[idx]; }
    }
    __syncthreads();
    { const int row = tid >> 2, qq = tid & 3; const ALAS float* src = CB + row * CBP + 32 * qq;
      f32x4 v[8]; float ss = 0.f;
#pragma unroll
      for (int j = 0; j < 8; ++j) { v[j] = *(const ALAS f32x4*)(src + 4 * j); ss += (v[j][0] * v[j][0] + v[j][1] * v[j][1]) + (v[j][2] * v[j][2] + v[j][3] * v[j][3]); }
      ss += __shfl_xor(ss, 1); ss += __shfl_xor(ss, 2);
      const float rsd = 0.8f / sqrtf(ss * (1.0f / 128.0f) + 1e-5f);
      bf16_t* dst = Oda + (size_t)(tokbase + q0 + row) * 512 + 128 * hd + 32 * qq;
#pragma unroll
      for (int j = 0; j < 4; ++j) { const f32x4 g0 = *(const f32x4*)(gsub + 32 * qq + 8 * j), g1 = *(const f32x4*)(gsub + 32 * qq + 8 * j + 4); const f32x4 a = v[2 * j] * rsd * g0, bq = v[2 * j + 1] * rsd * g1;
          u32x4 w; w.x = cvtpk(a[0], a[1]); w.y = cvtpk(a[2], a[3]); w.z = cvtpk(bq[0], bq[1]); w.w = cvtpk(bq[2], bq[3]); *(u32x4*)(dst + 8 * j) = w; } }
    __syncthreads();
}
}
#define LAS __attribute__((address_space(3)))
typedef unsigned short bf16;
typedef unsigned v4u __attribute__((ext_vector_type(4)));
typedef float f32x4 __attribute__((ext_vector_type(4)));
constexpr int NWAVES = 8;
constexpr int BATCH = 16, SEQ = 4096, D = 1024, M = BATCH * SEQ, INW = 5120, DFF = 2816, NFF2 = 2 * DFF;
constexpr size_t MiB = 1u << 20;
constexpr size_t WS_CTL = 0;
constexpr size_t WS_ROWSS = 64 * 1024;
constexpr size_t WS_ROPE = 1 * MiB;
constexpr size_t WS_WIN = 2 * MiB;
constexpr size_t WS_WBR = 12 * MiB;
constexpr size_t WS_WOUT = 14 * MiB;
constexpr size_t WS_WFFN = 16 * MiB;
constexpr size_t WS_WDN = 27 * MiB;
constexpr size_t WS_PROJ = 48 * MiB;
constexpr size_t WS_H = 688 * MiB;
constexpr size_t WS_O = 816 * MiB;
constexpr size_t WS_END = 944 * MiB;
constexpr int LDS_BYTES = 147456;
static_assert(att::ATT_LDS <= 131072, "attention LDS fits the ring");

__device__ __forceinline__ unsigned f2bf(float f) { unsigned u = __builtin_bit_cast(unsigned, f); return (u + 0x7fffu + ((u >> 16) & 1u)) >> 16; }
__device__ __forceinline__ unsigned pk2(float lo, float hi) { return f2bf(lo) | (f2bf(hi) << 16); }
__device__ __forceinline__ float wave_sum(float v) {
#pragma unroll
    for (int o = 1; o < 64; o <<= 1) v += __shfl_xor(v, o);
    return v;
}
__device__ __forceinline__ void transpose_item(const float* W, int ldw, int K, bf16* WT, int k0, int src_col, int dst_row0, const float* kscale, LAS float* scr, int lane) {
#pragma unroll 8
    for (int i = 0; i < 32; ++i) { const int kk = 2 * i + (lane >> 5); float v = W[(size_t)(k0 + kk) * ldw + src_col]; if (kscale) v *= kscale[k0 + kk]; scr[kk * 33 + (lane & 31)] = v; }
    asm volatile("s_waitcnt lgkmcnt(0)" ::: "memory");
    const int c = lane & 7;
#pragma unroll
    for (int j = 0; j < 4; ++j) { const int n = (lane >> 3) + 8 * j; const LAS float* s = scr + (8 * c) * 33 + n;
        v4u o; o.x = pk2(s[0 * 33], s[1 * 33]); o.y = pk2(s[2 * 33], s[3 * 33]); o.z = pk2(s[4 * 33], s[5 * 33]); o.w = pk2(s[6 * 33], s[7 * 33]);
        *(v4u*)(WT + (size_t)(dst_row0 + n) * K + k0 + 8 * c) = o; }
    asm volatile("s_waitcnt lgkmcnt(0)" ::: "memory");
}
__constant__ double ROPE_REV[32] = {0.15915494309189535, 0.11934937021124886, 0.089499401608891013, 0.067115083005227255, 0.050329212104487035, 0.037741584717419771, 0.028302195830623399, 0.02122365276477766,
    0.015915494309189534, 0.011934937021124886, 0.0089499401608891024, 0.0067115083005227253, 0.0050329212104487037, 0.0037741584717419772, 0.0028302195830623399, 0.0021223652764777662,
    0.0015915494309189536, 0.0011934937021124885, 0.00089499401608891024, 0.0006711508300522726, 0.00050329212104487033, 0.00037741584717419774, 0.00028302195830623395, 0.00021223652764777661,
    0.00015915494309189535, 0.00011934937021124886, 8.9499401608891018e-05, 6.7115083005227254e-05, 5.0329212104487035e-05, 3.7741584717419777e-05, 2.8302195830623396e-05, 2.1223652764777659e-05};

struct Args { const float* in[16]; float* out; unsigned char* ws; int ph_lo, ph_hi; };

__global__ void __launch_bounds__(NWAVES * 64, 2) fwd_mega(Args args) {
    extern __shared__ __attribute__((aligned(16))) unsigned char lds_raw[];
    LAS unsigned char* lds = (LAS unsigned char*)lds_raw;
    cg::grid_group grid = cg::this_grid();
    const int tid = threadIdx.x, lane = tid & 63, wave = __builtin_amdgcn_readfirstlane(tid >> 6);
    const int G = gridDim.x; const int bx = blockIdx.x; const int vcu = (G % 8 == 0) ? (bx % 8) * (G / 8) + bx / 8 : bx;
    unsigned char* ws = args.ws;
    const float* x = args.in[0]; float* out = args.out;
    float* lamp = (float*)(ws + WS_CTL); float* rowss = (float*)(ws + WS_ROWSS); float* ropec = (float*)(ws + WS_ROPE); float* ropes = ropec + 4096 * 32;
    bf16* Win_t = (bf16*)(ws + WS_WIN); bf16* Wbr_t = (bf16*)(ws + WS_WBR); bf16* Wout_t = (bf16*)(ws + WS_WOUT); bf16* Wffn_t = (bf16*)(ws + WS_WFFN); bf16* Wdn_t = (bf16*)(ws + WS_WDN);
    bf16* PROJ = (bf16*)(ws + WS_PROJ); bf16* UB = (bf16*)(ws + WS_PROJ); bf16* HB = (bf16*)(ws + WS_H); bf16* MX = (bf16*)(ws + WS_H); bf16* OB = (bf16*)(ws + WS_O); bf16* X1B = (bf16*)(ws + WS_O);
    const int lo = args.ph_lo, hi = args.ph_hi;
#define IN(k) (lo <= (k) && (k) < hi)
#define SEAM(k) do { if (IN(k) && IN((k) + 1)) grid.sync(); } while (0)

    if (IN(0)) {
        const int gw = vcu * NWAVES + wave, NGW = G * NWAVES; const int gt = bx * (NWAVES * 64) + tid, NGT = G * NWAVES * 64;
        LAS float* scr = (LAS float*)(lds + wave * 16384);
        constexpr int I_IN = (D / 64) * (INW / 32), I_BR = (512 / 64) * (D / 32), I_OUT = (D / 64) * (D / 32), I_FF = (D / 64) * (DFF / 32), I_DN = (DFF / 64) * (D / 32);
        constexpr int NITEMS = I_IN + 2 * I_BR + I_OUT + 2 * I_FF + I_DN;
        for (int it = gw; it < NITEMS; it += NGW) {
            int r = it; const int nl = lane & 31;
            if (r < I_IN) { const int nb = r % (INW / 32), kb = r / (INW / 32); const int n = nb * 32 + nl; int src = n;
                if (n >= 1536 && n < 2560) { const int j = n & 63; src = (n & ~63) + ((j & 1) ? 32 + (j >> 1) : (j >> 1)); }
                transpose_item(args.in[2], INW, D, Win_t, kb * 64, src, nb * 32, nullptr, scr, lane); continue; } r -= I_IN;
            if (r < I_BR) { const int nb = r % (D / 32), kb = r / (D / 32); transpose_item(args.in[8], D, 512, Wbr_t, kb * 64, nb * 32 + nl, nb * 32, nullptr, scr, lane); continue; } r -= I_BR;
            if (r < I_BR) { const int nb = r % (D / 32), kb = r / (D / 32); transpose_item(args.in[9], D, 512, Wbr_t, kb * 64, nb * 32 + nl, 1024 + nb * 32, nullptr, scr, lane); continue; } r -= I_BR;
            if (r < I_OUT) { const int nb = r % (D / 32), kb = r / (D / 32); transpose_item(args.in[10], D, D, Wout_t, kb * 64, nb * 32 + nl, nb * 32, nullptr, scr, lane); continue; } r -= I_OUT;
            if (r < 2 * I_FF) { const int half = r >= I_FF; if (half) r -= I_FF; const int nb = r % (DFF / 32), kb = r / (DFF / 32); const int n0 = nb * 32;
                transpose_item(args.in[half ? 13 : 12], DFF, D, Wffn_t, kb * 64, n0 + nl, 256 * (n0 / 128) + 128 * half + (n0 % 128), args.in[11], scr, lane); continue; } r -= 2 * I_FF;
            { const int nb = r % (D / 32), kb = r / (D / 32); transpose_item(args.in[14], D, DFF, Wdn_t, kb * 64, nb * 32 + nl, nb * 32, nullptr, scr, lane); }
        }
        for (int i = gt; i < 4096 * 32; i += NGT) { const int pos = i >> 5, f = i & 31; const double rev = (double)pos * ROPE_REV[f]; const float fr = (float)(rev - __builtin_rint(rev));
            ropec[i] = __builtin_amdgcn_cosf(fr); ropes[i] = __builtin_amdgcn_sinf(fr); }
        for (int i = gt; i < M; i += NGT) rowss[i] = 0.f;
        if (gt == 0) { float a = 0.f, b = 0.f; for (int i = 0; i < 64; ++i) { a += args.in[3][i] * args.in[4][i]; b += args.in[5][i] * args.in[6][i]; } lamp[0] = expf(a) - expf(b) + 0.2f; }
        const float* gm = args.in[1];
        f32x4 gv[4];
#pragma unroll
        for (int j = 0; j < 4; ++j) gv[j] = ((const f32x4*)gm)[lane + 64 * j];
        for (int m = gw; m < M; m += NGW) { const f32x4* xr = (const f32x4*)(x + (size_t)m * D) + lane; f32x4 v[4]; float s2 = 0.f;
#pragma unroll
            for (int j = 0; j < 4; ++j) { v[j] = xr[64 * j]; s2 += (v[j][0] * v[j][0] + v[j][1] * v[j][1]) + (v[j][2] * v[j][2] + v[j][3] * v[j][3]); }
            const float rstd = 1.0f / sqrtf(wave_sum(s2) * (1.f / D) + 1e-6f);
            unsigned long long* o8 = (unsigned long long*)(HB + (size_t)m * D) + lane;
#pragma unroll
            for (int j = 0; j < 4; ++j) { const f32x4 y = v[j] * rstd * gv[j]; o8[64 * j] = (unsigned long long)pk2(y[0], y[1]) | ((unsigned long long)pk2(y[2], y[3]) << 32); } }
    }
    SEAM(0);
    if (IN(1)) {
        pg8::Gemm g{HB, Win_t, M, INW, D}; pg8::StaticOrder S; S.init(M, INW, G, bx);
        pg8::EpiProj E{PROJ, ropec, ropes};
        pg8::gemm_phase<pg8::EpiProj, pg8::StaticOrder, true, true>(lds, g, S, E);
    }
    SEAM(1);
    if (IN(2)) {
        const float lam = lamp[0]; const float* gsub = args.in[7];
        for (int p = vcu; p < 1024; p += G) { const int bh = p >> 4, s = p & 15;
            att::da_unit(lds, PROJ, OB + (size_t)M * 512, gsub, lam, bh >> 2, bh & 3, s);
            att::da_unit(lds, PROJ, OB + (size_t)M * 512, gsub, lam, bh >> 2, bh & 3, 31 - s); }
        for (int p = vcu; p < 2048; p += G) { const int bh = p >> 5, qb = p & 31; att::sb_unit(lds, PROJ, OB, bh >> 2, bh & 3, qb); }
    }
    SEAM(2);
    if (IN(3)) {
        pg8::Gemm g{OB, Wbr_t, 2 * M, 2048, 512}; pg8::BranchOrder S; S.init(M, D, G, bx);
        pg8::EpiGate E{PROJ, MX};
        pg8::gemm_phase<pg8::EpiGate, pg8::BranchOrder, true, true>(lds, g, S, E);
    }
    SEAM(3);
    if (IN(4)) {
        pg8::Gemm g{MX, Wout_t, M, D, D}; pg8::StaticOrder S; S.init(M, D, G, bx);
        pg8::EpiOut E{x, out, X1B, rowss};
        pg8::gemm_phase<pg8::EpiOut, pg8::StaticOrder, true, true>(lds, g, S, E);
    }
    SEAM(4);
    if (IN(5)) {
        pg8::Gemm g{X1B, Wffn_t, M, NFF2, D}; pg8::StaticOrder S; S.init(M, NFF2, G, bx);
        pg8::EpiSwiGlu E{UB, rowss};
        pg8::gemm_phase<pg8::EpiSwiGlu, pg8::StaticOrder, true, true>(lds, g, S, E);
    }
    SEAM(5);
    if (IN(6)) {
        pg8::Gemm g{UB, Wdn_t, M, D, DFF}; pg8::StaticOrder S; S.init(M, D, G, bx);
        pg8::EpiDown E{out};
        pg8::gemm_phase<pg8::EpiDown, pg8::StaticOrder, true, true>(lds, g, S, E);
    }
    SEAM(6);
    if (IN(7)) {
        const int gw = vcu * NWAVES + wave, NGW = G * NWAVES; const float* gf = args.in[15];
        f32x4 gv[4];
#pragma unroll
        for (int j = 0; j < 4; ++j) gv[j] = ((const f32x4*)gf)[lane + 64 * j];
        for (int m = gw; m < M; m += NGW) { f32x4* xr = (f32x4*)(out + (size_t)m * D) + lane; f32x4 v[4]; float s2 = 0.f;
#pragma unroll
            for (int j = 0; j < 4; ++j) { v[j] = xr[64 * j]; s2 += (v[j][0] * v[j][0] + v[j][1] * v[j][1]) + (v[j][2] * v[j][2] + v[j][3] * v[j][3]); }
            const float rstd = 1.0f / sqrtf(wave_sum(s2) * (1.f / D) + 1e-6f);
#pragma unroll
            for (int j = 0; j < 4; ++j) xr[64 * j] = v[j] * rstd * gv[j]; }
    }
#undef IN
#undef SEAM
}

#ifndef MK_PER_PHASE
#define MK_PER_PHASE 0
#endif
extern "C" void kernel_launch(void* const* d_in, const int* in_sizes, int n_in, void* d_out, int out_size, void* d_ws, size_t ws_size, hipStream_t stream) {
    static int grid = 0;
    if (grid == 0) {
        if (n_in != 16 || in_sizes[0] != M * D || out_size != M * D || ws_size < WS_END) { fprintf(stderr, "kernel_launch: unexpected shapes (n_in %d, in0 %d, out %d, ws %zu)\n", n_in, n_in > 0 ? in_sizes[0] : -1, out_size, ws_size); grid = -1; return; }
        int dev = 0, cus = 0, per_cu = 0;
        hipGetDevice(&dev); hipDeviceGetAttribute(&cus, hipDeviceAttributeMultiprocessorCount, dev);
        if (hipFuncSetAttribute((const void*)fwd_mega, hipFuncAttributeMaxDynamicSharedMemorySize, LDS_BYTES) != hipSuccess) { fprintf(stderr, "kernel_launch: hipFuncSetAttribute failed\n"); grid = -1; return; }
        if (hipOccupancyMaxActiveBlocksPerMultiprocessor(&per_cu, (const void*)fwd_mega, NWAVES * 64, LDS_BYTES) != hipSuccess || per_cu < 1) { fprintf(stderr, "kernel_launch: occupancy query says %d\n", per_cu); per_cu = 1; }
        (void)hipGetLastError();
        grid = cus * per_cu;
    }
    if (grid < 0) return;
    Args a{};
    for (int i = 0; i < 16; ++i) a.in[i] = (const float*)d_in[i];
    a.out = (float*)d_out; a.ws = (unsigned char*)d_ws;
#if MK_PER_PHASE
    for (int p = 0; p < 8; ++p) { a.ph_lo = p; a.ph_hi = p + 1; void* kargs[] = {&a};
        hipError_t e = hipLaunchCooperativeKernel((const void*)fwd_mega, dim3(grid), dim3(NWAVES * 64), kargs, LDS_BYTES, stream);
        if (e != hipSuccess) { fprintf(stderr, "launch %d failed: %s\n", p, hipGetErrorString(e)); return; } }
#else
    a.ph_lo = 0; a.ph_hi = 8; void* kargs[] = {&a};
    hipError_t e = hipLaunchCooperativeKernel((const void*)fwd_mega, dim3(grid), dim3(NWAVES * 64), kargs, LDS_BYTES, stream);
    if (e != hipSuccess) fprintf(stderr, "cooperative launch failed: %s (grid %d)\n", hipGetErrorString(e), grid);
#endif
}
```

```cpp
#include <hip/hip_runtime.h>
#include <hip/hip_cooperative_groups.h>
#include <cstdio>
#include <cstdint>
namespace cg = cooperative_groups;
namespace pg8 {
#define PG8_LAS __attribute__((address_space(3)))
typedef unsigned short bf16_t;
typedef short bf16x8 __attribute__((ext_vector_type(8)));
typedef float f32x4 __attribute__((ext_vector_type(4)));
typedef unsigned u32x4 __attribute__((ext_vector_type(4)));
constexpr int BM = 256, BK = 64, HALF = 128, HTB = HALF * BK * 2  , STAGE_BYTES = 8 * HTB, NXCD = 8, WGM = 8;

__host__ __device__ __forceinline__ int lds_byte(int r, int c) { const int st = (r >> 4) * 2 + (c >> 5), rr = r & 15, cc = c & 31, ob = rr * 64 + cc * 2; return st * 1024 + (ob ^ (((ob >> 9) & 1) << 5)); }
__host__ __device__ __forceinline__ void stage_rc(int b, int& R, int& C) { const int st = b / 1024, sb = b % 1024, swz = sb ^ (((sb >> 9) & 1) << 5); R = (st >> 1) * 16 + swz / 64; C = (st & 1) * 32 + (swz % 64) / 2; }
__host__ __device__ __forceinline__ int perm32(int rho) { const int n = rho >> 4, i = rho & 15; return 8 * (i >> 2) + 4 * n + (i & 3); }

struct Unit { int pm, pn; };
struct Gemm { const bf16_t* A; const bf16_t* Bt; int M, N, K; };

struct StaticOrder {
    int nM, nN, nwg, G, c;
    __host__ __device__ void init(int M, int N, int G_, int c_) { nM = M / BM; nN = N / BM; nwg = nM * nN; G = G_; c = c_; }
    __host__ __device__ bool next(int i, Unit& u) const {
        const long L = (long)i * G + c; if (L >= nwg) return false;
        int wgid = (int)L; { const int q = nwg / NXCD, r = nwg % NXCD, xcd = wgid % NXCD, off = wgid / NXCD; wgid = (xcd < r ? xcd * (q + 1) : r * (q + 1) + (xcd - r) * q) + off; }
        const int nig = WGM * nN, gid = wgid / nig, fm = gid * WGM, gsz = (nM - fm) < WGM ? (nM - fm) : WGM;
        u.pm = fm + ((wgid % nig) % gsz); u.pn = (wgid % nig) / gsz; return true;
    }
    __device__ __forceinline__ void a_ready(const Unit&) const {}
    __device__ __forceinline__ void done(const Unit&) const {}
};

__device__ __forceinline__ unsigned cvt_pk_bf16(float lo, float hi) { typedef float f2 __attribute__((ext_vector_type(2))); typedef __bf16 b2 __attribute__((ext_vector_type(2))); f2 v = {lo, hi}; b2 b = __builtin_convertvector(v, b2); return __builtin_bit_cast(unsigned, b); }
__device__ __forceinline__ float bflo(unsigned w) { return __uint_as_float(w << 16); }
__device__ __forceinline__ float bfhi(unsigned w) { return __uint_as_float(w & 0xffff0000u); }
__device__ __forceinline__ float sigmoidf_(float x) { return __builtin_amdgcn_rcpf(1.0f + __builtin_amdgcn_exp2f(-1.4426950408889634f * x)); }
constexpr float QSCALE = 0.125f * 1.4426950408889634f;

struct EpiProj {
    static constexpr bool PERM = true, AFTER_DRAIN = false;
    bf16_t* O; const float* rc; const float* rs;
    __device__ __forceinline__ void operator()(const f32x4 (&acc)[2][2][4][2], const Unit& u, int wr, int wc, int fr, int fq) const {
        const int pn = u.pn; const bool rope = (pn >= 6 && pn < 10); const float sc = (pn < 2 || pn == 6 || pn == 7) ? QSCALE : 1.0f;
#pragma unroll
        for (int ai = 0; ai < 2; ++ai)
#pragma unroll
            for (int m = 0; m < 4; ++m) { const int row = u.pm * BM + ai * HALF + wr * 64 + m * 16 + fr; const int pos = row & 4095;
#pragma unroll
                for (int bj = 0; bj < 2; ++bj) { const int col0 = pn * BM + bj * HALF + wc * 32 + 8 * fq;
                    f32x4 v0 = acc[ai][bj][m][0], v1 = acc[ai][bj][m][1];
                    if (rope) { const int i0 = (col0 & 63) >> 1; const f32x4 c4 = *(const f32x4*)(rc + pos * 32 + i0), s4 = *(const f32x4*)(rs + pos * 32 + i0);
                        float a, b;
                        a = v0[0]; b = v0[1]; v0[0] = a * c4[0] - b * s4[0]; v0[1] = b * c4[0] + a * s4[0];
                        a = v0[2]; b = v0[3]; v0[2] = a * c4[1] - b * s4[1]; v0[3] = b * c4[1] + a * s4[1];
                        a = v1[0]; b = v1[1]; v1[0] = a * c4[2] - b * s4[2]; v1[1] = b * c4[2] + a * s4[2];
                        a = v1[2]; b = v1[3]; v1[2] = a * c4[3] - b * s4[3]; v1[3] = b * c4[3] + a * s4[3]; }
                    v0 = v0 * sc; v1 = v1 * sc;
                    u32x4 w; w.x = cvt_pk_bf16(v0[0], v0[1]); w.y = cvt_pk_bf16(v0[2], v0[3]); w.z = cvt_pk_bf16(v1[0], v1[1]); w.w = cvt_pk_bf16(v1[2], v1[3]);
                    *(u32x4*)(O + (size_t)row * 5120 + col0) = w; } }
    }
};
struct EpiGate {
    static constexpr bool PERM = true, AFTER_DRAIN = false;
    const bf16_t* P; bf16_t* Mx;
    __device__ __forceinline__ void operator()(const f32x4 (&acc)[2][2][4][2], const Unit& u, int wr, int wc, int fr, int fq) const {
        const int br = u.pm >> 8, pm = u.pm & 255, pn = u.pn & 3;
#pragma unroll
        for (int ai = 0; ai < 2; ++ai)
#pragma unroll
            for (int m = 0; m < 4; ++m) { const int row = pm * BM + ai * HALF + wr * 64 + m * 16 + fr;
#pragma unroll
                for (int bj = 0; bj < 2; ++bj) { const int col0 = pn * BM + bj * HALF + wc * 32 + 8 * fq;
                    const u32x4 g = *(const u32x4*)(P + (size_t)row * 5120 + 3072 + 1024 * br + col0);
                    f32x4 v0 = acc[ai][bj][m][0], v1 = acc[ai][bj][m][1];
                    v0[0] *= sigmoidf_(bflo(g.x)); v0[1] *= sigmoidf_(bfhi(g.x)); v0[2] *= sigmoidf_(bflo(g.y)); v0[3] *= sigmoidf_(bfhi(g.y));
                    v1[0] *= sigmoidf_(bflo(g.z)); v1[1] *= sigmoidf_(bfhi(g.z)); v1[2] *= sigmoidf_(bflo(g.w)); v1[3] *= sigmoidf_(bfhi(g.w));
                    bf16_t* dst = Mx + (size_t)row * 1024 + col0;
                    if (br) { const u32x4 p = *(const u32x4*)dst;
                        v0[0] += bflo(p.x); v0[1] += bfhi(p.x); v0[2] += bflo(p.y); v0[3] += bfhi(p.y); v1[0] += bflo(p.z); v1[1] += bfhi(p.z); v1[2] += bflo(p.w); v1[3] += bfhi(p.w); }
                    u32x4 w; w.x = cvt_pk_bf16(v0[0], v0[1]); w.y = cvt_pk_bf16(v0[2], v0[3]); w.z = cvt_pk_bf16(v1[0], v1[1]); w.w = cvt_pk_bf16(v1[2], v1[3]);
                    *(u32x4*)dst = w; } }
    }
};
struct EpiOut {
    static constexpr bool PERM = true, AFTER_DRAIN = false;
    const float* X; float* Out; bf16_t* Xb; float* rowss;
    __device__ __forceinline__ void operator()(const f32x4 (&acc)[2][2][4][2], const Unit& u, int wr, int wc, int fr, int fq) const {
#pragma unroll
        for (int ai = 0; ai < 2; ++ai)
#pragma unroll
            for (int m = 0; m < 4; ++m) { const int row = u.pm * BM + ai * HALF + wr * 64 + m * 16 + fr; float ss = 0.f;
#pragma unroll
                for (int bj = 0; bj < 2; ++bj) { const int col0 = u.pn * BM + bj * HALF + wc * 32 + 8 * fq; const size_t off = (size_t)row * 1024 + col0;
                    const f32x4 v0 = acc[ai][bj][m][0] + *(const f32x4*)(X + off), v1 = acc[ai][bj][m][1] + *(const f32x4*)(X + off + 4);
                    *(f32x4*)(Out + off) = v0; *(f32x4*)(Out + off + 4) = v1;
                    ss += (v0[0] * v0[0] + v0[1] * v0[1]) + (v0[2] * v0[2] + v0[3] * v0[3]) + (v1[0] * v1[0] + v1[1] * v1[1]) + (v1[2] * v1[2] + v1[3] * v1[3]);
                    u32x4 w; w.x = cvt_pk_bf16(v0[0], v0[1]); w.y = cvt_pk_bf16(v0[2], v0[3]); w.z = cvt_pk_bf16(v1[0], v1[1]); w.w = cvt_pk_bf16(v1[2], v1[3]);
                    *(u32x4*)(Xb + off) = w; }
                ss += __shfl_xor(ss, 16); ss += __shfl_xor(ss, 32);
                if (fq == 0) unsafeAtomicAdd(rowss + row, ss); }
    }
};
struct EpiSwiGlu {
    static constexpr bool PERM = true, AFTER_DRAIN = false;
    bf16_t* U; const float* rowss;
    __device__ __forceinline__ void operator()(const f32x4 (&acc)[2][2][4][2], const Unit& u, int wr, int wc, int fr, int fq) const {
#pragma unroll
        for (int ai = 0; ai < 2; ++ai)
#pragma unroll
            for (int m = 0; m < 4; ++m) { const int row = u.pm * BM + ai * HALF + wr * 64 + m * 16 + fr;
                const float rsd = 1.0f / sqrtf(rowss[row] * (1.0f / 1024.0f) + 1e-6f);
                const int col0 = u.pn * HALF + wc * 32 + 8 * fq;
                f32x4 o0, o1;
#pragma unroll
                for (int j = 0; j < 4; ++j) { const float g0 = acc[ai][0][m][0][j] * rsd, u0 = acc[ai][1][m][0][j] * rsd, g1 = acc[ai][0][m][1][j] * rsd, u1 = acc[ai][1][m][1][j] * rsd;
                    o0[j] = g0 * sigmoidf_(g0) * u0; o1[j] = g1 * sigmoidf_(g1) * u1; }
                u32x4 w; w.x = cvt_pk_bf16(o0[0], o0[1]); w.y = cvt_pk_bf16(o0[2], o0[3]); w.z = cvt_pk_bf16(o1[0], o1[1]); w.w = cvt_pk_bf16(o1[2], o1[3]);
                *(u32x4*)(U + (size_t)row * 2816 + col0) = w; }
    }
};
struct EpiDown {
    static constexpr bool PERM = true, AFTER_DRAIN = false;
    float* Out;
    __device__ __forceinline__ void operator()(const f32x4 (&acc)[2][2][4][2], const Unit& u, int wr, int wc, int fr, int fq) const {
#pragma unroll
        for (int ai = 0; ai < 2; ++ai)
#pragma unroll
            for (int m = 0; m < 4; ++m) { const int row = u.pm * BM + ai * HALF + wr * 64 + m * 16 + fr;
#pragma unroll
                for (int bj = 0; bj < 2; ++bj) { const int col0 = u.pn * BM + bj * HALF + wc * 32 + 8 * fq; float* p = Out + (size_t)row * 1024 + col0;
                    const f32x4 v0 = acc[ai][bj][m][0] + *(const f32x4*)p, v1 = acc[ai][bj][m][1] + *(const f32x4*)(p + 4);
                    *(f32x4*)p = v0; *(f32x4*)(p + 4) = v1; } }
    }
};
struct BranchOrder {
    StaticOrder base;
    __host__ __device__ void init(int M, int N, int G_, int c_) { base.init(M, N, G_, c_); }
    __host__ __device__ bool next(int i, Unit& u) const { Unit t; if (!base.next(i >> 1, t)) return false; const int br = i & 1; u.pm = t.pm + 256 * br; u.pn = t.pn + 4 * br; return true; }
    __device__ __forceinline__ void a_ready(const Unit&) const {}
    __device__ __forceinline__ void done(const Unit&) const {}
};
template <class Epi, class Sched, bool ALIGN_EPI = false, bool SP2 = false>
__device__ __forceinline__ void gemm_phase(PG8_LAS unsigned char* lds, const Gemm g, const Sched& S, const Epi& E) {
    const int tid = threadIdx.x, wid = __builtin_amdgcn_readfirstlane(tid >> 6), lane = tid & 63, wr = wid >> 2, wc = wid & 3, fr = lane & 15, fq = lane >> 4;
    const int K = g.K, nt = K / BK;
    unsigned voffA[2], voffB[2];
#pragma unroll
    for (int i = 0; i < 2; ++i) { int R, C; stage_rc(tid * 16 + i * 8192, R, C); const int Rb = Epi::PERM ? ((R & ~31) + perm32(R & 31)) : R;
        voffA[i] = (unsigned)(R * K + C) * 2u; voffB[i] = (unsigned)(Rb * K + C) * 2u; }
    const size_t kstep = (size_t)(BK * 2);
    const size_t hstep = (size_t)HALF * K * 2;
    const size_t tstep = 2 * hstep;
    const unsigned ldsw = (unsigned)wid * 1024u;
    const int aoff = lds_byte(wr * 64 + fr, fq * 8), boff = lds_byte(wc * 32 + fr, fq * 8);
#define PG8_SA(b, h) (((b) * 2 + (h)) * HTB)
#define PG8_SB(b, h) ((4 + (b) * 2 + (h)) * HTB)
#define PG8_STAGE(bufoff, gbase, voff) do { _Pragma("unroll") for (int _i = 0; _i < 2; ++_i) \
        __builtin_amdgcn_global_load_lds((const unsigned*)((const char*)(gbase) + (voff)[_i]), (PG8_LAS unsigned*)(lds + (bufoff) + ldsw + _i * 8192), 16, 0, 0); } while (0)
#define PG8_LDA(dst, b, h) do { _Pragma("unroll") for (int m = 0; m < 4; ++m) _Pragma("unroll") for (int k = 0; k < 2; ++k) dst[m][k] = *(const PG8_LAS bf16x8*)(lds + PG8_SA(b, h) + aoff + m * 2048 + k * 1024); } while (0)
#define PG8_LDB(dst, b, h) do { _Pragma("unroll") for (int n = 0; n < 2; ++n) _Pragma("unroll") for (int k = 0; k < 2; ++k) dst[n][k] = *(const PG8_LAS bf16x8*)(lds + PG8_SB(b, h) + boff + n * 2048 + k * 1024); } while (0)
#define PG8_MMA(ai, bj, At, Bt) do { __builtin_amdgcn_s_setprio(1); _Pragma("unroll") for (int m = 0; m < 4; ++m) _Pragma("unroll") for (int n = 0; n < 2; ++n) _Pragma("unroll") for (int k = 0; k < 2; ++k) \
        acc[ai][bj][m][n] = __builtin_amdgcn_mfma_f32_16x16x32_bf16(Bt[n][k], At[m][k], acc[ai][bj][m][n], 0, 0, 0); __builtin_amdgcn_s_setprio(0); } while (0)
#define PG8_WAIT_V(n) asm volatile("s_waitcnt vmcnt(" #n ")" ::: "memory")
#define PG8_WAIT_L(n) asm volatile("s_waitcnt lgkmcnt(" #n ")" ::: "memory")
#define PG8_BAR __builtin_amdgcn_s_barrier()
#define PG8_SCHED __builtin_amdgcn_sched_barrier(0)
    Unit cur, nxt; int ui = 0;
    if (!S.next(0, cur)) return;
    f32x4 acc[2][2][4][2];
#pragma unroll
    for (int a = 0; a < 2; ++a)
#pragma unroll
        for (int b = 0; b < 2; ++b)
#pragma unroll
            for (int m = 0; m < 4; ++m)
#pragma unroll
                for (int n = 0; n < 2; ++n) acc[a][b][m][n] = (f32x4){0.f, 0.f, 0.f, 0.f};
    bf16x8 At[4][2], B0[2][2], B1[2][2];
    const char* cA = (const char*)g.A + (size_t)cur.pm * tstep; const char* cB = (const char*)g.Bt + (size_t)cur.pn * tstep;
    S.a_ready(cur);
    if constexpr (SP2) {
        PG8_STAGE(PG8_SB(0, 0), cB, voffB); PG8_STAGE(PG8_SB(0, 1), cB + hstep, voffB); PG8_STAGE(PG8_SA(0, 0), cA, voffA); PG8_STAGE(PG8_SA(0, 1), cA + hstep, voffA);
        if (wr == 1) PG8_BAR;
        PG8_WAIT_V(2); PG8_BAR;
        PG8_STAGE(PG8_SB(1, 0), cB + kstep, voffB); PG8_STAGE(PG8_SA(1, 0), cA + kstep, voffA); PG8_STAGE(PG8_SB(1, 1), cB + hstep + kstep, voffB);
        PG8_WAIT_V(6); PG8_BAR;
    } else {
        PG8_STAGE(PG8_SB(0, 0), cB, voffB); PG8_STAGE(PG8_SA(0, 0), cA, voffA); PG8_STAGE(PG8_SB(0, 1), cB + hstep, voffB); PG8_STAGE(PG8_SA(0, 1), cA + hstep, voffA);
        if (wr == 1) PG8_BAR;
        PG8_WAIT_V(4); PG8_BAR;
        PG8_STAGE(PG8_SB(1, 0), cB + kstep, voffB); PG8_STAGE(PG8_SA(1, 0), cA + kstep, voffA); PG8_STAGE(PG8_SB(1, 1), cB + hstep + kstep, voffB);
        PG8_WAIT_V(6); PG8_BAR;
    }
    for (;;) {
        const bool has_next = S.next(ui + 1, nxt);
        const char* nA = has_next ? (const char*)g.A + (size_t)nxt.pm * tstep : cA; const char* nB = has_next ? (const char*)g.Bt + (size_t)nxt.pn * tstep : cB;
        for (int t = 0; t < nt; t += 2) {
            const bool last = (t == nt - 2);
            const char* a1 = cA + (size_t)(t + 1) * kstep;
            const char* a2 = last ? nA : cA + (size_t)(t + 2) * kstep; const char* b2 = last ? nB : cB + (size_t)(t + 2) * kstep;
            const char* a3 = a2 + kstep; const char* b3 = b2 + kstep;
            if (last && has_next) S.a_ready(nxt);
            if constexpr (SP2) {
            PG8_LDB(B0, 0, 0); PG8_LDB(B1, 0, 1); PG8_SCHED; PG8_LDA(At, 0, 0); PG8_STAGE(PG8_SA(1, 1), a1 + hstep, voffA);
            PG8_WAIT_V(8); PG8_WAIT_L(0); PG8_BAR; PG8_MMA(0, 0, At, B0); PG8_MMA(0, 1, At, B1); PG8_BAR; PG8_SCHED;
            PG8_LDA(At, 0, 1); PG8_STAGE(PG8_SB(0, 0), b2, voffB); PG8_STAGE(PG8_SB(0, 1), b2 + hstep, voffB); PG8_STAGE(PG8_SA(0, 0), a2, voffA);
            PG8_WAIT_V(8); PG8_WAIT_L(0); PG8_BAR; PG8_MMA(1, 0, At, B0); PG8_MMA(1, 1, At, B1); PG8_BAR; PG8_SCHED;
            PG8_LDB(B0, 1, 0); PG8_LDB(B1, 1, 1); PG8_SCHED; PG8_LDA(At, 1, 0); PG8_STAGE(PG8_SA(0, 1), a2 + hstep, voffA);
            PG8_WAIT_V(8); PG8_WAIT_L(0); PG8_BAR; PG8_MMA(0, 0, At, B0); PG8_MMA(0, 1, At, B1); PG8_BAR; PG8_SCHED;
            PG8_LDA(At, 1, 1); PG8_STAGE(PG8_SB(1, 0), b3, voffB); PG8_STAGE(PG8_SB(1, 1), b3 + hstep, voffB); PG8_STAGE(PG8_SA(1, 0), a3, voffA);
            PG8_WAIT_V(8); PG8_WAIT_L(0); PG8_BAR; PG8_MMA(1, 0, At, B0); PG8_MMA(1, 1, At, B1); PG8_BAR; PG8_SCHED;
            } else {
            PG8_LDB(B0, 0, 0); PG8_SCHED; PG8_LDA(At, 0, 0); PG8_STAGE(PG8_SA(1, 1), a1 + hstep, voffA);
            PG8_WAIT_L(8); PG8_BAR; PG8_WAIT_L(0); PG8_MMA(0, 0, At, B0); PG8_BAR; PG8_SCHED;
            PG8_LDB(B1, 0, 1); PG8_STAGE(PG8_SB(0, 0), b2, voffB);
            PG8_BAR; PG8_WAIT_L(0); PG8_MMA(0, 1, At, B1); PG8_BAR;
            PG8_LDA(At, 0, 1); PG8_STAGE(PG8_SA(0, 0), a2, voffA);
            PG8_BAR; PG8_WAIT_L(0); PG8_MMA(1, 0, At, B0); PG8_BAR; PG8_SCHED;
            PG8_STAGE(PG8_SB(0, 1), b2 + hstep, voffB);
            PG8_WAIT_V(6); PG8_BAR; PG8_MMA(1, 1, At, B1); PG8_BAR;
            PG8_LDB(B0, 1, 0); PG8_SCHED; PG8_LDA(At, 1, 0); PG8_STAGE(PG8_SA(0, 1), a2 + hstep, voffA);
            PG8_WAIT_L(8); PG8_BAR; PG8_WAIT_L(0); PG8_MMA(0, 0, At, B0); PG8_BAR; PG8_SCHED;
            PG8_LDB(B1, 1, 1); PG8_STAGE(PG8_SB(1, 0), b3, voffB);
            PG8_BAR; PG8_WAIT_L(0); PG8_MMA(0, 1, At, B1); PG8_BAR;
            PG8_LDA(At, 1, 1); PG8_STAGE(PG8_SA(1, 0), a3, voffA);
            PG8_BAR; PG8_WAIT_L(0); PG8_MMA(1, 0, At, B0); PG8_BAR; PG8_SCHED;
            PG8_STAGE(PG8_SB(1, 1), b3 + hstep, voffB);
            PG8_WAIT_V(6); PG8_BAR; PG8_MMA(1, 1, At, B1); PG8_BAR;
            }
        }
        if constexpr (ALIGN_EPI) { if (wr == 0) PG8_BAR; }
        if constexpr (!Epi::AFTER_DRAIN) { E(acc, cur, wr, wc, fr, fq); S.done(cur); }
        if (!has_next) break;
#pragma unroll
        for (int a = 0; a < 2; ++a)
#pragma unroll
            for (int b = 0; b < 2; ++b)
#pragma unroll
                for (int m = 0; m < 4; ++m)
#pragma unroll
                    for (int n = 0; n < 2; ++n) acc[a][b][m][n] = (f32x4){0.f, 0.f, 0.f, 0.f};
        cur = nxt; cA = nA; cB = nB; ++ui;
        if constexpr (ALIGN_EPI) { if (wr == 1) PG8_BAR; }
    }
    PG8_WAIT_V(0);
    if constexpr (!ALIGN_EPI) { if (wr == 0) PG8_BAR; }
    PG8_BAR;
    if constexpr (Epi::AFTER_DRAIN) { E.fused(acc, cur, wr, wc, fr, fq, lds, wid, lane); S.done(cur); }
#undef PG8_SA
#undef PG8_SB
#undef PG8_STAGE
#undef PG8_LDA
#undef PG8_LDB
#undef PG8_MMA
#undef PG8_WAIT_V
#undef PG8_WAIT_L
#undef PG8_BAR
#undef PG8_SCHED
}
}
namespace att {
typedef unsigned short bf16_t;
typedef short bf16x8 __attribute__((ext_vector_type(8)));
typedef short s16x4 __attribute__((ext_vector_type(4)));
typedef float f32x16 __attribute__((ext_vector_type(16)));
typedef unsigned u32x4 __attribute__((ext_vector_type(4)));
typedef float f32x4 __attribute__((ext_vector_type(4)));
#define ALAS __attribute__((address_space(3)))
constexpr int PITCH = 5120, SEQ = 4096;
constexpr int KP = 272, VP = 320, KBUF = 64 * KP, VBUF = 64 * VP, STG = KBUF + VBUF;
constexpr int NSTG = 3;
constexpr int OFF_WSF = NSTG * STG, OFF_FLAG = OFF_WSF + 8 * 64 * 4, ATT_LDS = OFF_FLAG + 64;
constexpr int CBP = 132;
static_assert(128 * CBP * 4 <= OFF_WSF, "combine buffer fits under the scratch");
constexpr float SB_DONE = -160.0f;

__device__ __forceinline__ int crow(int r, int hi) { return (r & 3) + 8 * (r >> 2) + 4 * hi; }
__device__ __forceinline__ unsigned cvtpk(float lo, float hi) { typedef float f2 __attribute__((ext_vector_type(2))); typedef __bf16 b2 __attribute__((ext_vector_type(2))); f2 v = {lo, hi}; b2 b = __builtin_convertvector(v, b2); return __builtin_bit_cast(unsigned, b); }
__device__ __forceinline__ float other_half(float v, int hi) { auto rr = __builtin_amdgcn_permlane32_swap(__float_as_uint(v), __float_as_uint(v), false, false); return __uint_as_float(hi ? rr[0] : rr[1]); }
#define MFMA32(a, b, c) __builtin_amdgcn_mfma_f32_32x32x16_bf16((a), (b), (c), 0, 0, 0)

struct TileRegs { u32x4 k0, k1, v0, v1; };
__device__ __forceinline__ void tile_load(TileRegs& R, const bf16_t* kbase, const bf16_t* vbase, int kv0, int tid) {
    const int row = tid >> 4, ch = tid & 15;
    const bf16_t* kp = kbase + (size_t)(kv0 + row) * PITCH + ch * 8; const bf16_t* vp = vbase + (size_t)(kv0 + row) * PITCH + ch * 8;
    R.k0 = *(const u32x4*)kp; R.k1 = *(const u32x4*)(kp + 32 * PITCH); R.v0 = *(const u32x4*)vp; R.v1 = *(const u32x4*)(vp + 32 * PITCH);
}
__device__ __forceinline__ void tile_store(ALAS unsigned char* stg, const TileRegs& R, int tid) {
    const int row = tid >> 4, ch = tid & 15;
    *(ALAS u32x4*)(stg + row * KP + ch * 16) = R.k0; *(ALAS u32x4*)(stg + (row + 32) * KP + ch * 16) = R.k1;
    *(ALAS u32x4*)(stg + KBUF + row * VP + ch * 16) = R.v0; *(ALAS u32x4*)(stg + KBUF + (row + 32) * VP + ch * 16) = R.v1;
}
__device__ __forceinline__ void qk_tile(f32x16& s0, f32x16& s1, const ALAS unsigned char* kb, const bf16x8* qr, const f32x16& init, int r32, int hi) {
    const ALAS unsigned char* p = kb + r32 * KP + hi * 16;
#pragma unroll
    for (int d0 = 0; d0 < 4; ++d0) {
        const bf16x8 a0 = *(const ALAS bf16x8*)(p + d0 * 32), a1 = *(const ALAS bf16x8*)(p + 32 * KP + d0 * 32);
        if (d0 == 0) { s0 = MFMA32(a0, qr[d0], init); s1 = MFMA32(a1, qr[d0], init); }
        else { s0 = MFMA32(a0, qr[d0], s0); s1 = MFMA32(a1, qr[d0], s1); } }
}
__device__ __forceinline__ bf16x8 pack8(const f32x16& x, const int s) {
    u32x4 p; p[0] = cvtpk(x[8 * s], x[8 * s + 1]); p[1] = cvtpk(x[8 * s + 2], x[8 * s + 3]); p[2] = cvtpk(x[8 * s + 4], x[8 * s + 5]); p[3] = cvtpk(x[8 * s + 6], x[8 * s + 7]);
    return __builtin_bit_cast(bf16x8, p);
}
typedef short v4i16_t __attribute__((ext_vector_type(4)));
__device__ __forceinline__ s16x4 vtr(const ALAS unsigned char* p) { return __builtin_bit_cast(s16x4, __builtin_amdgcn_ds_read_tr16_b64_v4i16((ALAS v4i16_t*)p)); }
template <int NDB> __device__ __forceinline__ void pv_tile(f32x16* o, const ALAS unsigned char* vb, const bf16x8 (&pa)[2][2], int lane) {
    const int i16 = lane & 15, q4 = i16 >> 2, p = i16 & 3, blk = (lane >> 4) & 1, hi = lane >> 5;
    const ALAS unsigned char* base = vb + (4 * hi + q4) * VP + blk * 32 + p * 8;
#pragma unroll
    for (int db = 0; db < NDB; ++db)
#pragma unroll
        for (int half = 0; half < 2; ++half)
#pragma unroll
            for (int s = 0; s < 2; ++s) {
                const s16x4 lo = vtr(base + (half * 32 + 16 * s) * VP + db * 64), hh = vtr(base + (half * 32 + 16 * s + 8) * VP + db * 64);
                const bf16x8 vf = __builtin_shufflevector(lo, hh, 0, 1, 2, 3, 4, 5, 6, 7);
                o[db] = MFMA32(pa[half][s], vf, o[db]); }
}
__device__ __forceinline__ void sb_half(const f32x16& z, f32x16& w, float& tot, float base, bool diag, int kv0, int qabs, int hi) {
    float lk[16], lb[16];
#pragma unroll
    for (int i = 0; i < 16; ++i) { const bool valid = !diag || (kv0 + crow(i, hi) < qabs);
        const float zz = z[i]; const float e = __builtin_amdgcn_exp2f(-__builtin_fabsf(zz)); const float sp = __builtin_fmaxf(zz, 0.f) + __builtin_amdgcn_logf(1.0f + e);
        lk[i] = valid ? -sp : 0.f; lb[i] = zz - sp; }
    float G[4], PG[4], T[4], ST[4];
#pragma unroll
    for (int g = 0; g < 4; ++g) { G[g] = (lk[4 * g] + lk[4 * g + 1]) + (lk[4 * g + 2] + lk[4 * g + 3]); PG[g] = other_half(G[g], hi); T[g] = G[g] + PG[g]; }
    ST[3] = 0.f; ST[2] = T[3]; ST[1] = ST[2] + T[2]; ST[0] = ST[1] + T[1]; tot = ST[0] + T[0];
#pragma unroll
    for (int g = 0; g < 4; ++g) { float b = base + ST[g] + (hi == 0 ? PG[g] : 0.f);
#pragma unroll
        for (int j = 3; j >= 0; --j) { const int i = 4 * g + j; const bool valid = !diag || (kv0 + crow(i, hi) < qabs);
            w[i] = valid ? __builtin_amdgcn_exp2f(lb[i] + b) : 0.f; b += lk[i]; } }
}
__device__ __forceinline__ void sb_unit(ALAS unsigned char* lds, const bf16_t* PROJ, bf16_t* Osb, int b, int hp, int qb) {
    const int tid = threadIdx.x, lane = tid & 63, r32 = lane & 31, hi = lane >> 5; const int wid = __builtin_amdgcn_readfirstlane(tid >> 6);
    const int c = wid >> 2, qs = wid & 3; const int tokbase = b * SEQ, q0 = qb * 128, qw0 = q0 + 32 * qs, qabs = qw0 + r32;
    const bf16_t* kbase = PROJ + (size_t)tokbase * PITCH + 512 + 128 * hp; const bf16_t* vbase = PROJ + (size_t)tokbase * PITCH + 1024 + 128 * hp;
    bf16x8 qr[4];
#pragma unroll
    for (int d0 = 0; d0 < 4; ++d0) qr[d0] = *(const bf16x8*)(PROJ + (size_t)(tokbase + qw0 + r32) * PITCH + 128 * hp + 64 * c + 16 * d0 + 8 * hi);
    const int T0 = (q0 >> 6) + 1, td = qw0 >> 6;
    f32x16 o[2];
#pragma unroll
    for (int i = 0; i < 16; ++i) { o[0][i] = 0.f; o[1][i] = 0.f; }
    float carry = 0.f; bool done = false;
    f32x16 zero16;
#pragma unroll
    for (int i = 0; i < 16; ++i) zero16[i] = 0.f;
    ALAS int* flag = (ALAS int*)(lds + OFF_FLAG);
    TileRegs R; tile_load(R, kbase, vbase, T0 * 64, tid); tile_store(lds, R, tid); __syncthreads();
    int it = 0;
    for (int t = T0;; --t, ++it) {
        const ALAS unsigned char* cur = lds + (it & 1) * STG; ALAS unsigned char* nxt = lds + ((it + 1) & 1) * STG;
        const bool has_next = t > 0;
        if (has_next) tile_load(R, kbase, vbase, (t - 1) * 64, tid);
        if (!done && t <= td) {
            f32x16 z0, z1; qk_tile(z0, z1, cur + c * 128, qr, zero16, r32, hi);
            const bool diag = (t == td); const int kvb = t * 64;
            f32x16 w0, w1; float tot1, tot0;
            sb_half(z1, w1, tot1, carry, diag, kvb + 32, qabs, hi);
            sb_half(z0, w0, tot0, carry + tot1, diag, kvb, qabs, hi);
            carry += tot1 + tot0;
            bf16x8 pa[2][2]; pa[0][0] = pack8(w0, 0); pa[0][1] = pack8(w0, 1); pa[1][0] = pack8(w1, 0); pa[1][1] = pack8(w1, 1);
            pv_tile<2>(o, cur + KBUF + c * 128, pa, lane);
            done = __all(carry < SB_DONE);
        }
        if (lane == 0) flag[(it & 1) * 8 + wid] = done ? 1 : 0;
        if (has_next) tile_store(nxt, R, tid);
        __syncthreads();
        int alld = 1;
#pragma unroll
        for (int w = 0; w < 8; ++w) alld &= flag[(it & 1) * 8 + w];
        if (!has_next || alld) break;
    }
    ALAS unsigned char* st = lds + wid * (32 * 144);
#pragma unroll
    for (int db = 0; db < 2; ++db)
#pragma unroll
        for (int i = 0; i < 16; ++i) *(ALAS bf16_t*)(st + crow(i, hi) * 144 + (32 * db + r32) * 2) = (bf16_t)(cvtpk(o[db][i], 0.f) & 0xffffu);
    __builtin_amdgcn_fence(__ATOMIC_RELEASE, "wavefront"); asm volatile("s_waitcnt lgkmcnt(0)" ::: "memory");
#pragma unroll
    for (int j = 0; j < 4; ++j) { const int idx = j * 64 + lane, row = idx >> 3, ch = idx & 7; const u32x4 v = *(const ALAS u32x4*)(st + row * 144 + ch * 16);
        *(u32x4*)(Osb + (size_t)(tokbase + qw0 + row) * 512 + 64 * (2 * hp + c) + ch * 8) = v; }
    __syncthreads();
}
__device__ __forceinline__ void da_unit(ALAS unsigned char* lds, const bf16_t* PROJ, bf16_t* Oda, const float* gsub, float lam, int b, int hd, int qb, int desc) {
    const int tid = threadIdx.x, lane = tid & 63, r32 = lane & 31, hi = lane >> 5; const int wid = __builtin_amdgcn_readfirstlane(tid >> 6);
    const int c = wid >> 2, qs = wid & 3; const int tokbase = b * SEQ, q0 = qb * 128, qw0 = q0 + 32 * qs;
    const bf16_t* kbase = PROJ + (size_t)tokbase * PITCH + 2048 + 128 * hd; const bf16_t* vbase = PROJ + (size_t)tokbase * PITCH + 2560 + 128 * hd;
    bf16x8 qr[4];
#pragma unroll
    for (int d0 = 0; d0 < 4; ++d0) qr[d0] = *(const bf16x8*)(PROJ + (size_t)(tokbase + qw0 + r32) * PITCH + 1536 + 128 * hd + 64 * c + 16 * d0 + 8 * hi);
    const int NT = (q0 >> 6) + 2, ntw = (qw0 >> 6) + 1;
    f32x16 o[4];
#pragma unroll
    for (int db = 0; db < 4; ++db)
#pragma unroll
        for (int i = 0; i < 16; ++i) o[db][i] = 0.f;
    float mref = 0.f, l = 0.f; bool first = true;
    f32x16 negm;
#pragma unroll
    for (int i = 0; i < 16; ++i) negm[i] = 0.f;
    bf16x8 pprev[2][2]; bool have_prev = false;
#pragma unroll
    for (int a = 0; a < 2; ++a)
#pragma unroll
        for (int bq = 0; bq < 2; ++bq) pprev[a][bq] = (bf16x8){0, 0, 0, 0, 0, 0, 0, 0};
    ALAS float* wsf = (ALAS float*)(lds + OFF_WSF) + wid * 64;
    const int tstep = desc ? -1 : 1;
    int tile = desc ? NT - 1 : 0;
    TileRegs R; tile_load(R, kbase, vbase, tile * 64, tid); tile_store(lds, R, tid); __syncthreads();
    int scur = 0;
    for (int t = 0; t < NT; ++t, tile += tstep) {
        const int snxt = (scur == NSTG - 1) ? 0 : scur + 1, sprv = (scur == 0) ? NSTG - 1 : scur - 1;
        const ALAS unsigned char* cur = lds + scur * STG; ALAS unsigned char* nxt = lds + snxt * STG;
        const bool has_next = t + 1 < NT;
        if (has_next) tile_load(R, kbase, vbase, (tile + tstep) * 64, tid);
        if (c == 1 && have_prev) { pv_tile<4>(o, lds + sprv * STG + KBUF, pprev, lane); have_prev = false; }
        if (tile < ntw) {
            f32x16 s0, s1; qk_tile(s0, s1, cur + c * 128, qr, negm, r32, hi);
            float mx = __builtin_fmaxf(s0[0], s1[0]);
#pragma unroll
            for (int i = 1; i < 16; ++i) mx = __builtin_fmaxf(mx, __builtin_fmaxf(s0[i], s1[i]));
            mx = __builtin_fmaxf(mx, other_half(mx, hi));
            if (first || __any(mx > 8.0f)) {
                const float dl = first ? mx : __builtin_fmaxf(mx, 0.f); const float f = first ? 1.0f : __builtin_amdgcn_exp2f(-dl);
                mref += dl; l *= f;
#pragma unroll
                for (int i = 0; i < 16; ++i) { s0[i] -= dl; s1[i] -= dl; negm[i] = -mref; }
                if (!first) {
                    if (hi == 0) wsf[r32] = f;
                    __builtin_amdgcn_fence(__ATOMIC_RELEASE, "wavefront"); asm volatile("s_waitcnt lgkmcnt(0)" ::: "memory");
#pragma unroll
                    for (int i = 0; i < 16; ++i) { const float fi = wsf[crow(i, hi)];
#pragma unroll
                        for (int db = 0; db < 4; ++db) o[db][i] *= fi; }
                }
                first = false;
            }
            float ls = 0.f;
#pragma unroll
            for (int i = 0; i < 16; ++i) { s0[i] = __builtin_amdgcn_exp2f(s0[i]); s1[i] = __builtin_amdgcn_exp2f(s1[i]); ls += s0[i] + s1[i]; }
            l += ls;
            bf16x8 pa[2][2]; pa[0][0] = pack8(s0, 0); pa[0][1] = pack8(s0, 1); pa[1][0] = pack8(s1, 0); pa[1][1] = pack8(s1, 1);
            if (c == 0) pv_tile<4>(o, cur + KBUF, pa, lane);
            else { pprev[0][0] = pa[0][0]; pprev[0][1] = pa[0][1]; pprev[1][0] = pa[1][0]; pprev[1][1] = pa[1][1]; have_prev = true; }
        }
        if (has_next) tile_store(nxt, R, tid);
        __syncthreads();
        scur = snxt;
    }
    if (c == 1 && have_prev) { const int sl = (scur == 0) ? NSTG - 1 : scur - 1; pv_tile<4>(o, lds + sl * STG + KBUF, pprev, lane); }
    __syncthreads();
    { const float lt = l + other_half(l, hi); const float inv = (c ? lam : 1.0f) / lt;
      if (hi == 0) wsf[r32] = inv;
      __builtin_amdgcn_fence(__ATOMIC_RELEASE, "wavefront"); asm volatile("s_waitcnt lgkmcnt(0)" ::: "memory");
#pragma unroll
      for (int i = 0; i < 16; ++i) { const float fi = wsf[crow(i, hi)];
#pragma unroll
          for (int db = 0; db < 4; ++db) o[db][i] *= fi; } }
    ALAS float* CB = (ALAS float*)lds;
    if (c == 1) {
#pragma unroll
        for (int db = 0; db < 4; ++db)
#pragma unroll
            for (int i = 0; i < 16; ++i) CB[(32 * qs + crow(i, hi)) * CBP + 32 * db + r32] = o[db][i];
    }
    __syncthreads();
    if (c == 0) {
#pragma unroll
        for (int db = 0; db < 4; ++db)
#pragma unroll
            for (int i = 0; i < 16; ++i) { const int idx = (32 * qs + crow(i, hi)) * CBP + 32 * db + r32; CB[idx] = o[db][i] - CB[idx]; }
    }
    __syncthreads();
    { const int row = tid >> 2, qq = tid & 3; const ALAS float* src = CB + row * CBP + 32 * qq;
      f32x4 v[8]; float ss = 0.f;
#pragma unroll
      for (int j = 0; j < 8; ++j) { v[j] = *(const ALAS f32x4*)(src + 4 * j); ss += (v[j][0] * v[j][0] + v[j][1] * v[j][1]) + (v[j][2] * v[j][2] + v[j][3] * v[j][3]); }
      ss += __shfl_xor(ss, 1); ss += __shfl_xor(ss, 2);
      const float rsd = 0.8f / sqrtf(ss * (1.0f / 128.0f) + 1e-5f);
      bf16_t* dst = Oda + (size_t)(tokbase + q0 + row) * 512 + 128 * hd + 32 * qq;
#pragma unroll
      for (int j = 0; j < 4; ++j) { const f32x4 g0 = *(const f32x4*)(gsub + 32 * qq + 8 * j), g1 = *(const f32x4*)(gsub + 32 * qq + 8 * j + 4); const f32x4 a = v[2 * j] * rsd * g0, bq = v[2 * j + 1] * rsd * g1;
          u32x4 w; w.x = cvtpk(a[0], a[1]); w.y = cvtpk(a[2], a[3]); w.z = cvtpk(bq[0], bq[1]); w.w = cvtpk(bq[2], bq[3]); *(u32x4*)(dst + 8 * j) = w; } }
    __syncthreads();
}
}
#define LAS __attribute__((address_space(3)))
typedef unsigned short bf16;
typedef unsigned v4u __attribute__((ext_vector_type(4)));
typedef float f32x4 __attribute__((ext_vector_type(4)));
constexpr int NWAVES = 8;
constexpr int BATCH = 16, SEQ = 4096, D = 1024, M = BATCH * SEQ, INW = 5120, DFF = 2816, NFF2 = 2 * DFF;
constexpr size_t MiB = 1u << 20;
constexpr size_t WS_CTL = 0;
constexpr size_t WS_BAR = 4096;
constexpr size_t WS_ROWSS = 64 * 1024;
constexpr size_t WS_ROPE = 1 * MiB;
constexpr size_t WS_WIN = 2 * MiB;
constexpr size_t WS_WBR = 12 * MiB;
constexpr size_t WS_WOUT = 14 * MiB;
constexpr size_t WS_WFFN = 16 * MiB;
constexpr size_t WS_WDN = 27 * MiB;
constexpr size_t WS_PROJ = 48 * MiB;
constexpr size_t WS_H = 688 * MiB;
constexpr size_t WS_O = 816 * MiB;
constexpr size_t WS_END = 944 * MiB;
constexpr int LDS_BYTES = 147456;
static_assert(att::ATT_LDS <= 131072, "attention LDS fits the ring");

__device__ __forceinline__ unsigned f2bf(float f) { unsigned u = __builtin_bit_cast(unsigned, f); return (u + 0x7fffu + ((u >> 16) & 1u)) >> 16; }
__device__ __forceinline__ unsigned pk2(float lo, float hi) { return f2bf(lo) | (f2bf(hi) << 16); }
__device__ __forceinline__ float wave_sum(float v) {
#pragma unroll
    for (int o = 1; o < 64; o <<= 1) v += __shfl_xor(v, o);
    return v;
}
__device__ __forceinline__ void transpose_item(const float* W, int ldw, int K, bf16* WT, int k0, int src_col, int dst_row0, const float* kscale, LAS float* scr, int lane) {
#pragma unroll 8
    for (int i = 0; i < 32; ++i) { const int kk = 2 * i + (lane >> 5); float v = W[(size_t)(k0 + kk) * ldw + src_col]; if (kscale) v *= kscale[k0 + kk]; scr[kk * 33 + (lane & 31)] = v; }
    asm volatile("s_waitcnt lgkmcnt(0)" ::: "memory");
    const int c = lane & 7;
#pragma unroll
    for (int j = 0; j < 4; ++j) { const int n = (lane >> 3) + 8 * j; const LAS float* s = scr + (8 * c) * 33 + n;
        v4u o; o.x = pk2(s[0 * 33], s[1 * 33]); o.y = pk2(s[2 * 33], s[3 * 33]); o.z = pk2(s[4 * 33], s[5 * 33]); o.w = pk2(s[6 * 33], s[7 * 33]);
        *(v4u*)(WT + (size_t)(dst_row0 + n) * K + k0 + 8 * c) = o; }
    asm volatile("s_waitcnt lgkmcnt(0)" ::: "memory");
}
__constant__ double ROPE_REV[32] = {0.15915494309189535, 0.11934937021124886, 0.089499401608891013, 0.067115083005227255, 0.050329212104487035, 0.037741584717419771, 0.028302195830623399, 0.02122365276477766,
    0.015915494309189534, 0.011934937021124886, 0.0089499401608891024, 0.0067115083005227253, 0.0050329212104487037, 0.0037741584717419772, 0.0028302195830623399, 0.0021223652764777662,
    0.0015915494309189536, 0.0011934937021124885, 0.00089499401608891024, 0.0006711508300522726, 0.00050329212104487033, 0.00037741584717419774, 0.00028302195830623395, 0.00021223652764777661,
    0.00015915494309189535, 0.00011934937021124886, 8.9499401608891018e-05, 6.7115083005227254e-05, 5.0329212104487035e-05, 3.7741584717419777e-05, 2.8302195830623396e-05, 2.1223652764777659e-05};

typedef __attribute__((address_space(1))) unsigned gu32;
#define XB_TMO      128
#define XB_XCNT(j)  (256  + 64 * (j))
#define XB_XSUB(j)  (1280 + 64 * (j))
#define XB_XGEN(j)  (2304 + 64 * (j))
#define XB_TOP      3328
#define XB_TOPGEN   3392
#define XCD_BAR_WORDS 3456
#define XB_SPIN_CAP (1u << 18)

__device__ __forceinline__ unsigned xb_ld(unsigned* p)              { return __hip_atomic_load(p, __ATOMIC_RELAXED, __HIP_MEMORY_SCOPE_AGENT); }
__device__ __forceinline__ unsigned xb_add(unsigned* p, unsigned v) { return __hip_atomic_fetch_add(p, v, __ATOMIC_RELAXED, __HIP_MEMORY_SCOPE_AGENT); }
__device__ __forceinline__ unsigned xb_xcc_id() { return (unsigned)__builtin_amdgcn_s_getreg((3 << 11) | 20) & 0xFu; }
#define XB_SPIN(cond, bar) do { unsigned _sp = 0; while (cond) { __builtin_amdgcn_s_sleep(1); \
    if ((++_sp & 255u) == 0u) { if (xb_ld(&(bar)[XB_TMO])) break; if (_sp > XB_SPIN_CAP) { atomicAdd(&(bar)[XB_TMO], 1u); break; } } } } while (0)

struct XcdBarrier {
    unsigned* bar; unsigned x;
    volatile LAS unsigned* st;
};

__device__ __forceinline__ XcdBarrier xcd_barrier_post(unsigned* bar, volatile LAS unsigned* st) {
    XcdBarrier b; b.bar = bar; b.x = xb_xcc_id(); b.st = st;
    if (threadIdx.x == 0) (void)xb_add(&bar[XB_XCNT(b.x)], 1u);
    return b;
}
__device__ __forceinline__ void xcd_barrier_complete(unsigned* bar, unsigned x, unsigned& nloc, unsigned& nx) {
    const unsigned G = gridDim.x * gridDim.y * gridDim.z;
    unsigned sum, cnt, mine, sp = 0u;
    for (;;) {
        sum = 0u; cnt = 0u; mine = 0u;
#pragma unroll
        for (unsigned j = 0; j < 16; ++j) { const unsigned c = xb_ld(&bar[XB_XCNT(j)]); sum += c; cnt += (c > 0u) ? 1u : 0u; mine = (j == x) ? c : mine; }
        if (sum == G) break;
        __builtin_amdgcn_s_sleep(1);
        if ((++sp & 255u) == 0u) { if (xb_ld(&bar[XB_TMO])) break; if (sp > XB_SPIN_CAP) { atomicAdd(&bar[XB_TMO], 1u); break; } }
    }
    nloc = mine > 0u ? mine : 1u; nx = cnt > 0u ? cnt : 1u;
}

__device__ __forceinline__ void xcd_barrier(const XcdBarrier& b) {
    asm volatile("s_waitcnt vmcnt(0)" ::: "memory");
    __syncthreads();
    if (threadIdx.x == 0) {
        unsigned* bar = b.bar;
        __builtin_amdgcn_s_waitcnt(0);
        unsigned nloc = b.st[0], nx = b.st[1];
        if (nloc == 0u) { xcd_barrier_complete(bar, b.x, nloc, nx); b.st[0] = nloc; b.st[1] = nx; }
        const unsigned old = xb_add(&bar[XB_XSUB(b.x)], 1u);
        const unsigned gen = old / nloc;
        if (old + 1u == (gen + 1u) * nloc) {
            __builtin_amdgcn_fence(__ATOMIC_RELEASE, "agent");
            asm volatile("s_waitcnt vmcnt(0)" ::: "memory");
            const unsigned og = xb_add(&bar[XB_TOP], 1u);
            const unsigned tg = og / nx;
            if (og + 1u == (tg + 1u) * nx) xb_add(&bar[XB_TOPGEN], 1u);
            else XB_SPIN(xb_ld(&bar[XB_TOPGEN]) == tg, bar);
            __builtin_amdgcn_fence(__ATOMIC_ACQUIRE, "agent");
            xb_add(&bar[XB_XGEN(b.x)], 1u);
            asm volatile("s_waitcnt vmcnt(0)" ::: "memory");
        } else {
            XB_SPIN(xb_ld(&bar[XB_XGEN(b.x)]) == gen, bar);
            __builtin_amdgcn_fence(__ATOMIC_ACQUIRE, "agent");
            asm volatile("s_waitcnt vmcnt(0)" ::: "memory");
        }
    }
    __syncthreads();
}

struct Args { const float* in[16]; float* out; unsigned char* ws; int ph_lo, ph_hi; };

__global__ void __launch_bounds__(NWAVES * 64, 2) fwd_mega(Args args) {
    extern __shared__ __attribute__((aligned(16))) unsigned char lds_raw[];
    LAS unsigned char* lds = (LAS unsigned char*)lds_raw;
    cg::grid_group grid = cg::this_grid();
    const int tid = threadIdx.x, lane = tid & 63, wave = __builtin_amdgcn_readfirstlane(tid >> 6);
    const int G = gridDim.x; const int bx = blockIdx.x; const int vcu = (G % 8 == 0) ? (bx % 8) * (G / 8) + bx / 8 : bx;
    unsigned char* ws = args.ws;
    const float* x = args.in[0]; float* out = args.out;
    float* lamp = (float*)(ws + WS_CTL); float* rowss = (float*)(ws + WS_ROWSS); float* ropec = (float*)(ws + WS_ROPE); float* ropes = ropec + 4096 * 32;
    bf16* Win_t = (bf16*)(ws + WS_WIN); bf16* Wbr_t = (bf16*)(ws + WS_WBR); bf16* Wout_t = (bf16*)(ws + WS_WOUT); bf16* Wffn_t = (bf16*)(ws + WS_WFFN); bf16* Wdn_t = (bf16*)(ws + WS_WDN);
    bf16* PROJ = (bf16*)(ws + WS_PROJ); bf16* UB = (bf16*)(ws + WS_PROJ); bf16* HB = (bf16*)(ws + WS_H); bf16* MX = (bf16*)(ws + WS_H); bf16* OB = (bf16*)(ws + WS_O); bf16* X1B = (bf16*)(ws + WS_O);
    const int lo = args.ph_lo, hi = args.ph_hi;
    volatile LAS unsigned* bst = (volatile LAS unsigned*)(lds + LDS_BYTES - 64);
    if (tid < 2) bst[tid] = 0u;
    __syncthreads();
    XcdBarrier xbar = xcd_barrier_post((unsigned*)(ws + WS_BAR), bst);
#define IN(k) (lo <= (k) && (k) < hi)
#define SEAM(k) do { if (IN(k) && IN((k) + 1)) { if ((k) == 0) grid.sync(); else xcd_barrier(xbar); } } while (0)

    if (IN(0)) {
        const int gw = vcu * NWAVES + wave, NGW = G * NWAVES; const int gt = bx * (NWAVES * 64) + tid, NGT = G * NWAVES * 64;
        LAS float* scr = (LAS float*)(lds + wave * 16384);
        constexpr int I_IN = (D / 64) * (INW / 32), I_BR = (512 / 64) * (D / 32), I_OUT = (D / 64) * (D / 32), I_FF = (D / 64) * (DFF / 32), I_DN = (DFF / 64) * (D / 32);
        constexpr int NITEMS = I_IN + 2 * I_BR + I_OUT + 2 * I_FF + I_DN;
        for (int it = gw; it < NITEMS; it += NGW) {
            int r = it; const int nl = lane & 31;
            if (r < I_IN) { const int nb = r % (INW / 32), kb = r / (INW / 32); const int n = nb * 32 + nl; int src = n;
                if (n >= 1536 && n < 2560) { const int j = n & 63; src = (n & ~63) + ((j & 1) ? 32 + (j >> 1) : (j >> 1)); }
                transpose_item(args.in[2], INW, D, Win_t, kb * 64, src, nb * 32, nullptr, scr, lane); continue; } r -= I_IN;
            if (r < I_BR) { const int nb = r % (D / 32), kb = r / (D / 32); transpose_item(args.in[8], D, 512, Wbr_t, kb * 64, nb * 32 + nl, nb * 32, nullptr, scr, lane); continue; } r -= I_BR;
            if (r < I_BR) { const int nb = r % (D / 32), kb = r / (D / 32); transpose_item(args.in[9], D, 512, Wbr_t, kb * 64, nb * 32 + nl, 1024 + nb * 32, nullptr, scr, lane); continue; } r -= I_BR;
            if (r < I_OUT) { const int nb = r % (D / 32), kb = r / (D / 32); transpose_item(args.in[10], D, D, Wout_t, kb * 64, nb * 32 + nl, nb * 32, nullptr, scr, lane); continue; } r -= I_OUT;
            if (r < 2 * I_FF) { const int half = r >= I_FF; if (half) r -= I_FF; const int nb = r % (DFF / 32), kb = r / (DFF / 32); const int n0 = nb * 32;
                transpose_item(args.in[half ? 13 : 12], DFF, D, Wffn_t, kb * 64, n0 + nl, 256 * (n0 / 128) + 128 * half + (n0 % 128), args.in[11], scr, lane); continue; } r -= 2 * I_FF;
            { const int nb = r % (D / 32), kb = r / (D / 32); transpose_item(args.in[14], D, DFF, Wdn_t, kb * 64, nb * 32 + nl, nb * 32, nullptr, scr, lane); }
        }
        for (int i = gt; i < 4096 * 32; i += NGT) { const int pos = i >> 5, f = i & 31; const double rev = (double)pos * ROPE_REV[f]; const float fr = (float)(rev - __builtin_rint(rev));
            ropec[i] = __builtin_amdgcn_cosf(fr); ropes[i] = __builtin_amdgcn_sinf(fr); }
        for (int i = gt; i < M; i += NGT) rowss[i] = 0.f;
        if (gt == 0) { float a = 0.f, b = 0.f; for (int i = 0; i < 64; ++i) { a += args.in[3][i] * args.in[4][i]; b += args.in[5][i] * args.in[6][i]; } lamp[0] = expf(a) - expf(b) + 0.2f; }
        const float* gm = args.in[1];
        f32x4 gv[4];
#pragma unroll
        for (int j = 0; j < 4; ++j) gv[j] = ((const f32x4*)gm)[lane + 64 * j];
        for (int m = gw; m < M; m += NGW) { const f32x4* xr = (const f32x4*)(x + (size_t)m * D) + lane; f32x4 v[4]; float s2 = 0.f;
#pragma unroll
            for (int j = 0; j < 4; ++j) { v[j] = xr[64 * j]; s2 += (v[j][0] * v[j][0] + v[j][1] * v[j][1]) + (v[j][2] * v[j][2] + v[j][3] * v[j][3]); }
            const float rstd = 1.0f / sqrtf(wave_sum(s2) * (1.f / D) + 1e-6f);
            unsigned long long* o8 = (unsigned long long*)(HB + (size_t)m * D) + lane;
#pragma unroll
            for (int j = 0; j < 4; ++j) { const f32x4 y = v[j] * rstd * gv[j]; o8[64 * j] = (unsigned long long)pk2(y[0], y[1]) | ((unsigned long long)pk2(y[2], y[3]) << 32); } }
    }
    SEAM(0);
    if (IN(1)) {
        pg8::Gemm g{HB, Win_t, M, INW, D}; pg8::StaticOrder S; S.init(M, INW, G, bx);
        pg8::EpiProj E{PROJ, ropec, ropes};
        pg8::gemm_phase<pg8::EpiProj, pg8::StaticOrder, true, true>(lds, g, S, E);
    }
    SEAM(1);
    if (IN(2)) {
        const float lam = lamp[0]; const float* gsub = args.in[7];
        if (G == 256) {
            const int xg = vcu >> 5, j = vcu & 31;
            for (int r = 0; r < 4; ++r) { const int bh1 = xg * 8 + 2 * r, bh2 = bh1 + 1;
                att::da_unit(lds, PROJ, OB + (size_t)M * 512, gsub, lam, bh1 >> 2, bh1 & 3, j, 0);
                att::da_unit(lds, PROJ, OB + (size_t)M * 512, gsub, lam, bh2 >> 2, bh2 & 3, 31 - j, 1); }
        } else {
            for (int p = vcu; p < 2048; p += G) { const int bh = p >> 5; att::da_unit(lds, PROJ, OB + (size_t)M * 512, gsub, lam, bh >> 2, bh & 3, p & 31, 0); }
        }
        for (int p = vcu; p < 2048; p += G) { const int bh = p >> 5, qb = p & 31; att::sb_unit(lds, PROJ, OB, bh >> 2, bh & 3, qb); }
    }
    SEAM(2);
    if (IN(3)) {
        pg8::Gemm g{OB, Wbr_t, 2 * M, 2048, 512}; pg8::BranchOrder S; S.init(M, D, G, bx);
        pg8::EpiGate E{PROJ, MX};
        pg8::gemm_phase<pg8::EpiGate, pg8::BranchOrder, true, true>(lds, g, S, E);
    }
    SEAM(3);
    if (IN(4)) {
        pg8::Gemm g{MX, Wout_t, M, D, D}; pg8::StaticOrder S; S.init(M, D, G, bx);
        pg8::EpiOut E{x, out, X1B, rowss};
        pg8::gemm_phase<pg8::EpiOut, pg8::StaticOrder, true, true>(lds, g, S, E);
    }
    SEAM(4);
    if (IN(5)) {
        pg8::Gemm g{X1B, Wffn_t, M, NFF2, D}; pg8::StaticOrder S; S.init(M, NFF2, G, bx);
        pg8::EpiSwiGlu E{UB, rowss};
        pg8::gemm_phase<pg8::EpiSwiGlu, pg8::StaticOrder, true, true>(lds, g, S, E);
    }
    SEAM(5);
    if (IN(6)) {
        pg8::Gemm g{UB, Wdn_t, M, D, DFF}; pg8::StaticOrder S; S.init(M, D, G, bx);
        pg8::EpiDown E{out};
        pg8::gemm_phase<pg8::EpiDown, pg8::StaticOrder, true, true>(lds, g, S, E);
    }
    SEAM(6);
    if (IN(7)) {
        const int gw = vcu * NWAVES + wave, NGW = G * NWAVES; const float* gf = args.in[15];
        f32x4 gv[4];
#pragma unroll
        for (int j = 0; j < 4; ++j) gv[j] = ((const f32x4*)gf)[lane + 64 * j];
        for (int m = gw; m < M; m += NGW) { f32x4* xr = (f32x4*)(out + (size_t)m * D) + lane; f32x4 v[4]; float s2 = 0.f;
#pragma unroll
            for (int j = 0; j < 4; ++j) { v[j] = xr[64 * j]; s2 += (v[j][0] * v[j][0] + v[j][1] * v[j][1]) + (v[j][2] * v[j][2] + v[j][3] * v[j][3]); }
            const float rstd = 1.0f / sqrtf(wave_sum(s2) * (1.f / D) + 1e-6f);
#pragma unroll
            for (int j = 0; j < 4; ++j) xr[64 * j] = v[j] * rstd * gv[j]; }
    }
#undef IN
#undef SEAM
}

#ifndef MK_PER_PHASE
#define MK_PER_PHASE 0
#endif
extern "C" void kernel_launch(void* const* d_in, const int* in_sizes, int n_in, void* d_out, int out_size, void* d_ws, size_t ws_size, hipStream_t stream) {
    static int grid = 0;
    if (grid == 0) {
        if (n_in != 16 || in_sizes[0] != M * D || out_size != M * D || ws_size < WS_END) { fprintf(stderr, "kernel_launch: unexpected shapes (n_in %d, in0 %d, out %d, ws %zu)\n", n_in, n_in > 0 ? in_sizes[0] : -1, out_size, ws_size); grid = -1; return; }
        int dev = 0, cus = 0, per_cu = 0;
        hipGetDevice(&dev); hipDeviceGetAttribute(&cus, hipDeviceAttributeMultiprocessorCount, dev);
        if (hipFuncSetAttribute((const void*)fwd_mega, hipFuncAttributeMaxDynamicSharedMemorySize, LDS_BYTES) != hipSuccess) { fprintf(stderr, "kernel_launch: hipFuncSetAttribute failed\n"); grid = -1; return; }
        if (hipOccupancyMaxActiveBlocksPerMultiprocessor(&per_cu, (const void*)fwd_mega, NWAVES * 64, LDS_BYTES) != hipSuccess || per_cu < 1) { fprintf(stderr, "kernel_launch: occupancy query says %d\n", per_cu); per_cu = 1; }
        (void)hipGetLastError();
        grid = cus * per_cu;
    }
    if (grid < 0) return;
    if (hipMemsetAsync(d_ws, 0, 65536, stream) != hipSuccess) { fprintf(stderr, "kernel_launch: memset failed\n"); return; }
    Args a{};
    for (int i = 0; i < 16; ++i) a.in[i] = (const float*)d_in[i];
    a.out = (float*)d_out; a.ws = (unsigned char*)d_ws;
#if MK_PER_PHASE
    for (int p = 0; p < 8; ++p) { a.ph_lo = p; a.ph_hi = p + 1; void* kargs[] = {&a};
        hipError_t e = hipLaunchCooperativeKernel((const void*)fwd_mega, dim3(grid), dim3(NWAVES * 64), kargs, LDS_BYTES, stream);
        if (e != hipSuccess) { fprintf(stderr, "launch %d failed: %s\n", p, hipGetErrorString(e)); return; } }
#else
    a.ph_lo = 0; a.ph_hi = 8; void* kargs[] = {&a};
    hipError_t e = hipLaunchCooperativeKernel((const void*)fwd_mega, dim3(grid), dim3(NWAVES * 64), kargs, LDS_BYTES, stream);
    if (e != hipSuccess) fprintf(stderr, "cooperative launch failed: %s (grid %d)\n", hipGetErrorString(e), grid);
#endif
}
```
